# Optimizing an MI355X kernel written in HIP

```python
import math
import jax, jax.numpy as jnp
from jax import lax
import numpy as np

D_MODEL = 1024
BATCH = 4
SEQ = 4096
DEPTH = 4
DEC_BATCH = 32
DEC_SEQ = 8
PAST_LEN = 8192
PAGE_SIZE = 128

N_A_LAYERS = DEPTH // 2
N_B_LAYERS = DEPTH - N_A_LAYERS
HEAD_DIM = 64
MIX_WIDTH = D_MODEL
MEM_HEADS = 4
MEM_DIM = MEM_HEADS * HEAD_DIM
N_MEM = 256
CONV_DIM = MIX_WIDTH - MEM_DIM
CONV_WIDTH = 3
NSA_HEADS = (MIX_WIDTH - MEM_DIM) // HEAD_DIM
NSA_KV_HEADS = 4
NSA_GROUP = NSA_HEADS // NSA_KV_HEADS
NSA_DIM = NSA_HEADS * HEAD_DIM
KV_DIM = NSA_KV_HEADS * HEAD_DIM
CMP_STRIDE = 16
CMP_LEN = 2 * CMP_STRIDE
CMP_HID = 2 * HEAD_DIM
SEL_BLOCK = 64
N_SEL = 16
WINDOW = 512
Q_BLOCK = 64
D_FF = -(-8 * D_MODEL // (3 * 256)) * 256
RMS_EPS = 1e-6
NEG_INF = -1e30
FORCE_SCORE = 1e4
ATT_SCALE = HEAD_DIM ** -0.5

kernel_name = 'yoco_shortconv_nsa_memory_decode_step'


def _alibi_list(n):
    def pow2(m):
        start = 2.0 ** (-8.0 / m)
        return [start ** (i + 1) for i in range(m)]
    if n & (n - 1) == 0:
        return pow2(n)
    c = 2 ** int(math.floor(math.log2(n)))
    return pow2(c) + _alibi_list(2 * c)[0::2][: n - c]


def rmsnorm(x, g):
    x32 = x.astype(jnp.float32)
    y = x32 * lax.rsqrt(jnp.mean(x32 * x32, axis=-1, keepdims=True) + RMS_EPS)
    return (y * g.astype(jnp.float32)).astype(x.dtype)


def swiglu(h, w_gu, w_dn):
    gate, up = jnp.split(h @ w_gu, 2, axis=-1)
    return (jax.nn.silu(gate) * up) @ w_dn


def short_conv(proj, conv_w, state):
    b_gate, c_gate, h = jnp.split(proj, 3, axis=-1)
    u = c_gate * h
    t = u.shape[1]
    u_ext = jnp.concatenate([state.astype(u.dtype), u], axis=1)
    y = conv_w[0] * u_ext[:, 0:t]
    for j in range(1, CONV_WIDTH):
        y = y + conv_w[j] * u_ext[:, j:j + t]
    return b_gate * y, u_ext[:, t:]


def mem_attention(mq, mk, mv):
    b, t = mq.shape[:2]
    q = mq.reshape(b, t, MEM_HEADS, HEAD_DIM)
    s = jnp.einsum('bthd,bmhd->bhtm', q, mk).astype(jnp.float32) * ATT_SCALE
    p = jax.nn.softmax(s, axis=-1).astype(mv.dtype)
    return jnp.einsum('bhtm,bmhd->bthd', p, mv).reshape(b, t, MEM_DIM)


def mix_a(h, conv_state, mk, mv, w_in, conv_w):
    proj = h @ w_in
    y_conv, new_state = short_conv(proj[..., :3 * CONV_DIM], conv_w, conv_state)
    y_mem = mem_attention(proj[..., 3 * CONV_DIM:], mk, mv)
    return jnp.concatenate([y_conv, y_mem], axis=-1), new_state


def project_b(h, w_in):
    proj = h @ w_in
    b, t = h.shape[:2]
    q = proj[..., :NSA_DIM].reshape(b, t, NSA_HEADS, HEAD_DIM)
    gates = jax.nn.sigmoid(proj[..., NSA_DIM:NSA_DIM + 3 * NSA_HEADS]).reshape(b, t, NSA_HEADS, 3)
    mq = proj[..., NSA_DIM + 3 * NSA_HEADS:]
    return q, gates, mq


def shared_kv(x, g_kv, w_kv):
    b, t = x.shape[:2]
    return (rmsnorm(x, g_kv) @ w_kv).reshape(b, t, 3, 2, NSA_KV_HEADS, HEAD_DIM)


def gather_pages(pool, page_table):
    g = pool[page_table]
    return g.reshape(page_table.shape[0], page_table.shape[1] * pool.shape[1], *pool.shape[2:])


def compress_blocks(k, pe, w1, w2):
    b, t = k.shape[:2]
    n_chunks = -(-t // CMP_STRIDE)
    k = jnp.pad(k, ((0, 0), (0, n_chunks * CMP_STRIDE - t), (0, 0), (0, 0)))
    ch = k.reshape(b, n_chunks, CMP_STRIDE, NSA_KV_HEADS, HEAD_DIM)
    lead = jnp.einsum('bcjkd,jde->bcke', ch + pe[None, None, :CMP_STRIDE, None, :], w1[:CMP_STRIDE])
    tail = jnp.einsum('bcjkd,jde->bcke', ch + pe[None, None, CMP_STRIDE:, None, :], w1[CMP_STRIDE:])
    out = jax.nn.silu(lead[:, :-1] + tail[:, 1:]) @ w2
    end_pos = jnp.arange(n_chunks - 1, dtype=jnp.int32) * CMP_STRIDE + (CMP_LEN - 1)
    return out, end_pos


def sel_blocks(k):
    b, t = k.shape[:2]
    n_sb = max(-(-t // SEL_BLOCK), N_SEL)
    k = jnp.pad(k, ((0, 0), (0, n_sb * SEL_BLOCK - t), (0, 0), (0, 0)))
    return k.reshape(b, n_sb, SEL_BLOCK, NSA_KV_HEADS, HEAD_DIM).transpose(0, 3, 1, 2, 4)


def nsa_context(cmp_rows, slc_rows, pe_ck, w1_ck, w2_ck, pe_cv, w1_cv, w2_cv):
    ck, c_end = compress_blocks(cmp_rows[:, :, 0], pe_ck, w1_ck, w2_ck)
    cv, _ = compress_blocks(cmp_rows[:, :, 1], pe_cv, w1_cv, w2_cv)
    return (ck, cv, c_end, sel_blocks(slc_rows[:, :, 0]), sel_blocks(slc_rows[:, :, 1]))


def nsa_block(q, gates, q_pos, ck, cv, c_end, ks_blk, vs_blk, kw, vw, w_pos, slopes):
    b, tq = q.shape[:2]
    qg = q.reshape(b, tq, NSA_KV_HEADS, NSA_GROUP, HEAD_DIM)
    sl = slopes.reshape(NSA_KV_HEADS, NSA_GROUP)
    s_c = jnp.einsum('btkgd,bnkd->btkgn', qg, ck).astype(jnp.float32) * ATT_SCALE
    dist_c = q_pos[:, None] - c_end[None, :]
    vis_c = dist_c >= 0
    s_c = s_c - sl[None, None, :, :, None] * dist_c.astype(jnp.float32)[None, :, None, None, :]
    s_c = jnp.where(vis_c[None, :, None, None, :], s_c, NEG_INF)
    any_c = jnp.any(vis_c, axis=-1).astype(jnp.float32)
    p_c = jax.nn.softmax(s_c, axis=-1) * any_c[None, :, None, None, None]
    o_c = jnp.einsum('btkgn,bnkd->btkgd', p_c.astype(cv.dtype), cv)
    n_sb = ks_blk.shape[2]
    per = SEL_BLOCK // CMP_STRIDE
    imp = p_c.sum(axis=3)
    imp = jnp.pad(imp, ((0, 0), (0, 0), (0, 0), (0, n_sb * per - imp.shape[-1])))
    imp = imp.reshape(b, tq, NSA_KV_HEADS, n_sb, per).sum(-1)
    blk = jnp.arange(n_sb, dtype=jnp.int32)[None, :]
    cur = (q_pos // SEL_BLOCK)[:, None]
    causal_b = blk <= cur
    forced = (blk == 0) | (blk == cur) | (blk == cur - 1)
    score = jnp.where(forced[None, :, None, :], FORCE_SCORE,
                      jnp.where(causal_b[None, :, None, :], imp, -jnp.inf))
    _, idx = lax.top_k(score, N_SEL)
    idx = idx.transpose(0, 2, 1, 3)
    b_ix = jnp.arange(b)[:, None, None, None]
    k_ix = jnp.arange(NSA_KV_HEADS)[None, :, None, None]
    ks = ks_blk[b_ix, k_ix, idx]
    vs = vs_blk[b_ix, k_ix, idx]
    pos_s = idx[..., None] * SEL_BLOCK + jnp.arange(SEL_BLOCK, dtype=jnp.int32)
    dist_s = q_pos[None, None, :, None, None] - pos_s
    qt = qg.transpose(0, 2, 1, 3, 4)
    s_s = jnp.einsum('bktgd,bktsld->bktgsl', qt, ks).astype(jnp.float32) * ATT_SCALE
    s_s = s_s - sl[None, :, None, :, None, None] * dist_s[:, :, :, None].astype(jnp.float32)
    s_s = jnp.where((dist_s >= 0)[:, :, :, None], s_s, NEG_INF)
    p_s = jax.nn.softmax(s_s.reshape(*s_s.shape[:4], N_SEL * SEL_BLOCK), axis=-1).reshape(s_s.shape)
    o_s = jnp.einsum('bktgsl,bktsld->bktgd', p_s.astype(vs.dtype), vs).transpose(0, 2, 1, 3, 4)
    s_w = jnp.einsum('btkgd,blkd->btkgl', qg, kw).astype(jnp.float32) * ATT_SCALE
    dist_w = q_pos[:, None] - w_pos[None, :]
    vis_w = (dist_w >= 0) & (dist_w <= WINDOW) & (w_pos >= 0)[None, :]
    s_w = s_w - sl[None, None, :, :, None] * dist_w.astype(jnp.float32)[None, :, None, None, :]
    s_w = jnp.where(vis_w[None, :, None, None, :], s_w, NEG_INF)
    p_w = jax.nn.softmax(s_w, axis=-1)
    o_w = jnp.einsum('btkgl,blkd->btkgd', p_w.astype(vw.dtype), vw)
    gg = gates.reshape(b, tq, NSA_KV_HEADS, NSA_GROUP, 3)
    o = gg[..., 0:1] * o_c + gg[..., 1:2] * o_s + gg[..., 2:3] * o_w
    return o.reshape(b, tq, NSA_DIM)


def nsa_prompt(q, gates, ctx, win_rows, slopes):
    ck, cv, c_end, ks_blk, vs_blk = ctx
    b, t = q.shape[:2]
    nqb = t // Q_BLOCK
    win_pad = jnp.pad(win_rows, ((0, 0), (WINDOW, 0), (0, 0), (0, 0), (0, 0)))
    q_b = q.reshape(b, nqb, Q_BLOCK, NSA_HEADS, HEAD_DIM).swapaxes(0, 1)
    g_b = gates.reshape(b, nqb, Q_BLOCK, NSA_HEADS, 3).swapaxes(0, 1)

    def one_block(args):
        i, qb, gb = args
        start = i * Q_BLOCK
        q_pos = start + jnp.arange(Q_BLOCK, dtype=jnp.int32)
        wb = lax.dynamic_slice_in_dim(win_pad, start, WINDOW + Q_BLOCK, axis=1)
        w_pos = start - WINDOW + jnp.arange(WINDOW + Q_BLOCK, dtype=jnp.int32)
        return nsa_block(qb, gb, q_pos, ck, cv, c_end, ks_blk, vs_blk, wb[:, :, 0], wb[:, :, 1], w_pos, slopes)

    out = lax.map(one_block, (jnp.arange(nqb, dtype=jnp.int32), q_b, g_b))
    return out.swapaxes(0, 1).reshape(b, t, NSA_DIM)


def setup_inputs(seed: int = 0) -> dict:
    key = jax.random.key(seed)
    ks = jax.random.split(key, 32)
    f32 = jnp.float32
    n_pages = PAST_LEN // PAGE_SIZE
    n_pool = (5 * DEC_BATCH * n_pages + 3) // 4
    win_len = min(WINDOW, PAST_LEN)

    def nrm(k, shape, scale=1.0):
        return jax.random.normal(k, shape, f32) * scale

    def gain(k, shape):
        return 1.0 + 0.02 * jax.random.normal(k, shape, f32)

    page_table = jax.random.permutation(ks[0], n_pool)[: DEC_BATCH * n_pages].reshape(DEC_BATCH, n_pages).astype(jnp.int32)
    return {
        'x_prompt': nrm(ks[1], (BATCH, SEQ, D_MODEL)),
        'x_sample': nrm(ks[2], (DEC_BATCH, DEC_SEQ, D_MODEL)),
        'state_conv': nrm(ks[3], (N_A_LAYERS, DEC_BATCH, CONV_WIDTH - 1, CONV_DIM)),
        'cache_mem_kv': nrm(ks[4], (DEPTH, DEC_BATCH, N_MEM, 2, MEM_HEADS, HEAD_DIM)),
        'cache_cmp_kv': nrm(ks[5], (n_pool, PAGE_SIZE, 2, NSA_KV_HEADS, HEAD_DIM)),
        'cache_slc_kv': nrm(ks[6], (n_pool, PAGE_SIZE, 2, NSA_KV_HEADS, HEAD_DIM)),
        'state_win_kv': nrm(ks[7], (DEC_BATCH, win_len, 2, NSA_KV_HEADS, HEAD_DIM)),
        'page_table': page_table,
        'mem_prompt': nrm(ks[8], (BATCH, N_MEM, D_MODEL)),
        'g_mix': gain(ks[9], (DEPTH, D_MODEL)),
        'w_in_a': nrm(ks[10], (N_A_LAYERS, D_MODEL, 3 * CONV_DIM + MEM_DIM), D_MODEL ** -0.5),
        'conv_w': nrm(ks[11], (N_A_LAYERS, CONV_WIDTH, CONV_DIM), CONV_WIDTH ** -0.5),
        'w_in_b': nrm(ks[12], (N_B_LAYERS, D_MODEL, NSA_DIM + 3 * NSA_HEADS + MEM_DIM), D_MODEL ** -0.5),
        'w_o': nrm(ks[13], (DEPTH, MIX_WIDTH, D_MODEL), MIX_WIDTH ** -0.5),
        'w_mkv': nrm(ks[14], (DEPTH, D_MODEL, 2 * MEM_DIM), D_MODEL ** -0.5),
        'g_mem': gain(ks[15], (D_MODEL,)),
        'g_kv': gain(ks[16], (D_MODEL,)),
        'w_kv': nrm(ks[17], (D_MODEL, 6 * KV_DIM), D_MODEL ** -0.5),
        'pe_ck': nrm(ks[18], (CMP_LEN, HEAD_DIM), 0.1),
        'w1_ck': nrm(ks[19], (CMP_LEN, HEAD_DIM, CMP_HID), (CMP_LEN * HEAD_DIM) ** -0.5),
        'w2_ck': nrm(ks[20], (CMP_HID, HEAD_DIM), CMP_HID ** -0.5),
        'pe_cv': nrm(ks[21], (CMP_LEN, HEAD_DIM), 0.1),
        'w1_cv': nrm(ks[22], (CMP_LEN, HEAD_DIM, CMP_HID), (CMP_LEN * HEAD_DIM) ** -0.5),
        'w2_cv': nrm(ks[23], (CMP_HID, HEAD_DIM), CMP_HID ** -0.5),
        'g_ffn': gain(ks[24], (DEPTH, D_MODEL)),
        'w_gu': nrm(ks[25], (DEPTH, D_MODEL, 2 * D_FF), D_MODEL ** -0.5),
        'w_dn': nrm(ks[26], (DEPTH, D_FF, D_MODEL), D_FF ** -0.5),
        'g_final': gain(ks[27], (D_MODEL,)),
    }


def reference(x_prompt, x_sample, state_conv, cache_mem_kv, cache_cmp_kv, cache_slc_kv, state_win_kv,
              page_table, mem_prompt, g_mix, w_in_a, conv_w, w_in_b, w_o, w_mkv, g_mem, g_kv, w_kv,
              pe_ck, w1_ck, w2_ck, pe_cv, w1_cv, w2_cv, g_ffn, w_gu, w_dn, g_final):
    slopes = jnp.asarray(np.array(_alibi_list(NSA_HEADS), dtype=np.float32))
    bp, tp = x_prompt.shape[:2]
    bs, ts = x_sample.shape[:2]
    n_mem = mem_prompt.shape[1]
    win_len = state_win_kv.shape[1]
    mem_kv_p = jnp.einsum('bmd,lde->lbme', rmsnorm(mem_prompt, g_mem), w_mkv).reshape(
        DEPTH, bp, n_mem, 2, MEM_HEADS, HEAD_DIM)
    xp, xs = x_prompt, x_sample
    conv_p, conv_s = [], []
    for l in range(DEPTH):
        mk_p, mv_p = mem_kv_p[l, :, :, 0], mem_kv_p[l, :, :, 1]
        mk_s, mv_s = cache_mem_kv[l, :, :, 0], cache_mem_kv[l, :, :, 1]
        hp = rmsnorm(xp, g_mix[l])
        hs = rmsnorm(xs, g_mix[l])
        if l < N_A_LAYERS:
            zero_state = jnp.zeros((bp, CONV_WIDTH - 1, CONV_DIM), xp.dtype)
            yp, st_p = mix_a(hp, zero_state, mk_p, mv_p, w_in_a[l], conv_w[l])
            ys, st_s = mix_a(hs, state_conv[l], mk_s, mv_s, w_in_a[l], conv_w[l])
            conv_p.append(st_p)
            conv_s.append(st_s)
        else:
            if l == N_A_LAYERS:
                kv_p = shared_kv(xp, g_kv, w_kv)
                kv_s = shared_kv(xs, g_kv, w_kv)
                cmp_new_p, slc_new_p, win_new_p = kv_p[:, :, 0], kv_p[:, :, 1], kv_p[:, :, 2]
                cmp_new_s, slc_new_s, win_new_s = kv_s[:, :, 0], kv_s[:, :, 1], kv_s[:, :, 2]
                full_cmp_s = jnp.concatenate([gather_pages(cache_cmp_kv, page_table).astype(cmp_new_s.dtype), cmp_new_s], axis=1)
                full_slc_s = jnp.concatenate([gather_pages(cache_slc_kv, page_table).astype(slc_new_s.dtype), slc_new_s], axis=1)
                ctx_p = nsa_context(cmp_new_p, slc_new_p, pe_ck, w1_ck, w2_ck, pe_cv, w1_cv, w2_cv)
                ctx_s = nsa_context(full_cmp_s, full_slc_s, pe_ck, w1_ck, w2_ck, pe_cv, w1_cv, w2_cv)
                win_full_s = jnp.concatenate([state_win_kv.astype(win_new_s.dtype), win_new_s], axis=1)
                q_pos_s = PAST_LEN + jnp.arange(ts, dtype=jnp.int32)
                w_pos_s = PAST_LEN - win_len + jnp.arange(win_len + ts, dtype=jnp.int32)
            j = l - N_A_LAYERS
            qp, gp, mqp = project_b(hp, w_in_b[j])
            qs, gs, mqs = project_b(hs, w_in_b[j])
            yp = jnp.concatenate([nsa_prompt(qp, gp, ctx_p, win_new_p, slopes),
                                  mem_attention(mqp, mk_p, mv_p)], axis=-1)
            ys = jnp.concatenate([nsa_block(qs, gs, q_pos_s, *ctx_s, win_full_s[:, :, 0], win_full_s[:, :, 1], w_pos_s, slopes),
                                  mem_attention(mqs, mk_s, mv_s)], axis=-1)
        xp = xp + yp @ w_o[l]
        xs = xs + ys @ w_o[l]
        xp = xp + swiglu(rmsnorm(xp, g_ffn[l]), w_gu[l], w_dn[l])
        xs = xs + swiglu(rmsnorm(xs, g_ffn[l]), w_gu[l], w_dn[l])
    y_prompt = rmsnorm(xp, g_final)
    y_sample = rmsnorm(xs, g_final)
    conv_state_p = jnp.stack(conv_p)
    conv_state_s = jnp.stack(conv_s)
    win_kv_p = win_new_p[:, tp - min(WINDOW, tp):]
    win_kv_s = win_full_s[:, ts:]
    return (y_prompt, y_sample, conv_state_p, conv_state_s, mem_kv_p, cmp_new_p, slc_new_p, win_kv_p, cmp_new_s, slc_new_s, win_kv_s)
```

```cpp
#include <hip/hip_runtime.h>
#include <cstdio>
#include <cstdint>
namespace pg8 {
#define PG8_LAS __attribute__((address_space(3)))
typedef unsigned short bf16_t;
typedef short bf16x8 __attribute__((ext_vector_type(8)));
typedef float f32x4 __attribute__((ext_vector_type(4)));
typedef unsigned u32x4 __attribute__((ext_vector_type(4)));
constexpr int BM = 256, BK = 64, HALF = 128, HTB = HALF * BK * 2  , STAGE_BYTES = 8 * HTB, NXCD = 8, WGM = 8;

__host__ __device__ __forceinline__ int lds_byte(int r, int c) { const int st = (r >> 4) * 2 + (c >> 5), rr = r & 15, cc = c & 31, ob = rr * 64 + cc * 2; return st * 1024 + (ob ^ (((ob >> 9) & 1) << 5)); }
__host__ __device__ __forceinline__ void stage_rc(int b, int& R, int& C) { const int st = b / 1024, sb = b % 1024, swz = sb ^ (((sb >> 9) & 1) << 5); R = (st >> 1) * 16 + swz / 64; C = (st & 1) * 32 + (swz % 64) / 2; }
__host__ __device__ __forceinline__ int perm32(int rho) { const int n = rho >> 4, i = rho & 15; return 8 * (i >> 2) + 4 * n + (i & 3); }

struct Unit { int pm, pn; };
struct Gemm { const bf16_t* A; const bf16_t* Bt; int M, N, K; };
struct StaticOrder {
    int nM, nN, nwg, G, c;
    __host__ __device__ void init(int M, int N, int G_, int c_) { nM = M / BM; nN = N / BM; nwg = nM * nN; G = G_; c = c_; }
    __host__ __device__ bool next(int i, Unit& u) const {
        const long L = (long)i * G + c; if (L >= nwg) return false;
        int wgid = (int)L; { const int q = nwg / NXCD, r = nwg % NXCD, xcd = wgid % NXCD, off = wgid / NXCD; wgid = (xcd < r ? xcd * (q + 1) : r * (q + 1) + (xcd - r) * q) + off; }
        const int nig = WGM * nN, gid = wgid / nig, fm = gid * WGM, gsz = (nM - fm) < WGM ? (nM - fm) : WGM;
        u.pm = fm + ((wgid % nig) % gsz); u.pn = (wgid % nig) / gsz; return true;
    }
    __device__ __forceinline__ void a_ready(const Unit&) const {}
    __device__ __forceinline__ void done(const Unit&) const {}
};

__device__ __forceinline__ unsigned cvt_pk_bf16(float lo, float hi) { unsigned r; asm volatile("v_cvt_pk_bf16_f32 %0, %1, %2" : "=v"(r) : "v"(lo), "v"(hi)); return r; }
typedef float f32x2 __attribute__((ext_vector_type(2)));

template <class Epi, class Sched, bool ALIGN_EPI = false, bool SP2 = false>
__device__ __forceinline__ void gemm_phase(PG8_LAS unsigned char* lds, const Gemm g, const Sched& S, const Epi& E, const int tid) {
    const int wid = __builtin_amdgcn_readfirstlane(tid >> 6), lane = tid & 63, wr = wid >> 2, wc = wid & 3, fr = lane & 15, fq = lane >> 4;
    const int K = g.K, nt = K / BK;
    unsigned voffA[2], voffB[2];
#pragma unroll
    for (int i = 0; i < 2; ++i) { int R, C; stage_rc(tid * 16 + i * 8192, R, C); const int Rb = Epi::PERM ? ((R & ~31) + perm32(R & 31)) : R;
        voffA[i] = (unsigned)(R * K + C) * 2u; voffB[i] = (unsigned)(Rb * K + C) * 2u; }
    const size_t kstep = (size_t)(BK * 2);
    const size_t hstep = (size_t)HALF * K * 2;
    const size_t tstep = 2 * hstep;
    const unsigned ldsw = (unsigned)wid * 1024u;
    const int aoff = lds_byte(wr * 64 + fr, fq * 8), boff = lds_byte(wc * 32 + fr, fq * 8);
#define PG8_SA(b, h) (((b) * 2 + (h)) * HTB)
#define PG8_SB(b, h) ((4 + (b) * 2 + (h)) * HTB)
#define PG8_STAGE(bufoff, gbase, voff) do { _Pragma("unroll") for (int _i = 0; _i < 2; ++_i) \
        __builtin_amdgcn_global_load_lds((const unsigned*)((const char*)(gbase) + (voff)[_i]), (PG8_LAS unsigned*)(lds + (bufoff) + ldsw + _i * 8192), 16, 0, 0); } while (0)
#define PG8_LDA(dst, b, h) do { _Pragma("unroll") for (int m = 0; m < 4; ++m) _Pragma("unroll") for (int k = 0; k < 2; ++k) dst[m][k] = *(const PG8_LAS bf16x8*)(lds + PG8_SA(b, h) + aoff + m * 2048 + k * 1024); } while (0)
#define PG8_LDB(dst, b, h) do { _Pragma("unroll") for (int n = 0; n < 2; ++n) _Pragma("unroll") for (int k = 0; k < 2; ++k) dst[n][k] = *(const PG8_LAS bf16x8*)(lds + PG8_SB(b, h) + boff + n * 2048 + k * 1024); } while (0)
#define PG8_MMA(ai, bj, At, Bt) do { __builtin_amdgcn_s_setprio(1); _Pragma("unroll") for (int m = 0; m < 4; ++m) _Pragma("unroll") for (int n = 0; n < 2; ++n) _Pragma("unroll") for (int k = 0; k < 2; ++k) \
        acc[ai][bj][m][n] = __builtin_amdgcn_mfma_f32_16x16x32_bf16(Bt[n][k], At[m][k], acc[ai][bj][m][n], 0, 0, 0); __builtin_amdgcn_s_setprio(0); } while (0)
#define PG8_WAIT_V(n) asm volatile("s_waitcnt vmcnt(" #n ")" ::: "memory")
#define PG8_WAIT_L(n) asm volatile("s_waitcnt lgkmcnt(" #n ")" ::: "memory")
#define PG8_BAR __builtin_amdgcn_s_barrier()
#define PG8_SCHED __builtin_amdgcn_sched_barrier(0)
    Unit cur, nxt; int ui = 0;
    if (!S.next(0, cur)) return;
    f32x4 acc[2][2][4][2];
#pragma unroll
    for (int a = 0; a < 2; ++a)
#pragma unroll
        for (int b = 0; b < 2; ++b)
#pragma unroll
            for (int m = 0; m < 4; ++m)
#pragma unroll
                for (int n = 0; n < 2; ++n) acc[a][b][m][n] = (f32x4){0.f, 0.f, 0.f, 0.f};
    bf16x8 At[4][2], B0[2][2], B1[2][2];
    unsigned long long pre_[8];
    const char* cA = (const char*)g.A + (size_t)cur.pm * tstep; const char* cB = (const char*)g.Bt + (size_t)cur.pn * tstep;
    S.a_ready(cur);
    if constexpr (SP2) {
        PG8_STAGE(PG8_SB(0, 0), cB, voffB); PG8_STAGE(PG8_SB(0, 1), cB + hstep, voffB); PG8_STAGE(PG8_SA(0, 0), cA, voffA); PG8_STAGE(PG8_SA(0, 1), cA + hstep, voffA);
        if (wr == 1) PG8_BAR;
        PG8_WAIT_V(2); PG8_BAR;
        PG8_STAGE(PG8_SB(1, 0), cB + kstep, voffB); PG8_STAGE(PG8_SA(1, 0), cA + kstep, voffA); PG8_STAGE(PG8_SB(1, 1), cB + hstep + kstep, voffB);
        PG8_WAIT_V(6); PG8_BAR;
    } else {
        PG8_STAGE(PG8_SB(0, 0), cB, voffB); PG8_STAGE(PG8_SA(0, 0), cA, voffA); PG8_STAGE(PG8_SB(0, 1), cB + hstep, voffB); PG8_STAGE(PG8_SA(0, 1), cA + hstep, voffA);
        if (wr == 1) PG8_BAR;
        PG8_WAIT_V(4); PG8_BAR;
        PG8_STAGE(PG8_SB(1, 0), cB + kstep, voffB); PG8_STAGE(PG8_SA(1, 0), cA + kstep, voffA); PG8_STAGE(PG8_SB(1, 1), cB + hstep + kstep, voffB);
        PG8_WAIT_V(6); PG8_BAR;
    }
    for (;;) {
        const bool has_next = S.next(ui + 1, nxt);
        const char* nA = has_next ? (const char*)g.A + (size_t)nxt.pm * tstep : cA; const char* nB = has_next ? (const char*)g.Bt + (size_t)nxt.pn * tstep : cB;
        for (int t = 0; t < nt; t += 2) {
            const bool last = (t == nt - 2);
            const char* a1 = cA + (size_t)(t + 1) * kstep;
            const char* a2 = last ? nA : cA + (size_t)(t + 2) * kstep; const char* b2 = last ? nB : cB + (size_t)(t + 2) * kstep;
            const char* a3 = a2 + kstep; const char* b3 = b2 + kstep;
            if (last && has_next) S.a_ready(nxt);
            if constexpr (Epi::PRE) { if (last) E.pre(cur, wr, fr, pre_); }
            if constexpr (SP2) {
            PG8_LDB(B0, 0, 0); PG8_LDB(B1, 0, 1); PG8_SCHED; PG8_LDA(At, 0, 0); PG8_STAGE(PG8_SA(1, 1), a1 + hstep, voffA);
            PG8_WAIT_V(8); PG8_WAIT_L(0); PG8_BAR; PG8_MMA(0, 0, At, B0); PG8_MMA(0, 1, At, B1); PG8_BAR; PG8_SCHED;
            PG8_LDA(At, 0, 1); PG8_STAGE(PG8_SB(0, 0), b2, voffB); PG8_STAGE(PG8_SB(0, 1), b2 + hstep, voffB); PG8_STAGE(PG8_SA(0, 0), a2, voffA);
            PG8_WAIT_V(8); PG8_WAIT_L(0); PG8_BAR; PG8_MMA(1, 0, At, B0); PG8_MMA(1, 1, At, B1); PG8_BAR; PG8_SCHED;
            PG8_LDB(B0, 1, 0); PG8_LDB(B1, 1, 1); PG8_SCHED; PG8_LDA(At, 1, 0); PG8_STAGE(PG8_SA(0, 1), a2 + hstep, voffA);
            PG8_WAIT_V(8); PG8_WAIT_L(0); PG8_BAR; PG8_MMA(0, 0, At, B0); PG8_MMA(0, 1, At, B1); PG8_BAR; PG8_SCHED;
            PG8_LDA(At, 1, 1); PG8_STAGE(PG8_SB(1, 0), b3, voffB); PG8_STAGE(PG8_SB(1, 1), b3 + hstep, voffB); PG8_STAGE(PG8_SA(1, 0), a3, voffA);
            PG8_WAIT_V(8); PG8_WAIT_L(0); PG8_BAR; PG8_MMA(1, 0, At, B0); PG8_MMA(1, 1, At, B1); PG8_BAR; PG8_SCHED;
            } else {
            PG8_LDB(B0, 0, 0); PG8_SCHED; PG8_LDA(At, 0, 0); PG8_STAGE(PG8_SA(1, 1), a1 + hstep, voffA);
            PG8_WAIT_L(8); PG8_BAR; PG8_WAIT_L(0); PG8_MMA(0, 0, At, B0); PG8_BAR; PG8_SCHED;
            PG8_LDB(B1, 0, 1); PG8_STAGE(PG8_SB(0, 0), b2, voffB);
            PG8_BAR; PG8_WAIT_L(0); PG8_MMA(0, 1, At, B1); PG8_BAR;
            PG8_LDA(At, 0, 1); PG8_STAGE(PG8_SA(0, 0), a2, voffA);
            PG8_BAR; PG8_WAIT_L(0); PG8_MMA(1, 0, At, B0); PG8_BAR; PG8_SCHED;
            PG8_STAGE(PG8_SB(0, 1), b2 + hstep, voffB);
            PG8_WAIT_V(6); PG8_BAR; PG8_MMA(1, 1, At, B1); PG8_BAR;
            PG8_LDB(B0, 1, 0); PG8_SCHED; PG8_LDA(At, 1, 0); PG8_STAGE(PG8_SA(0, 1), a2 + hstep, voffA);
            PG8_WAIT_L(8); PG8_BAR; PG8_WAIT_L(0); PG8_MMA(0, 0, At, B0); PG8_BAR; PG8_SCHED;
            PG8_LDB(B1, 1, 1); PG8_STAGE(PG8_SB(1, 0), b3, voffB);
            PG8_BAR; PG8_WAIT_L(0); PG8_MMA(0, 1, At, B1); PG8_BAR;
            PG8_LDA(At, 1, 1); PG8_STAGE(PG8_SA(1, 0), a3, voffA);
            PG8_BAR; PG8_WAIT_L(0); PG8_MMA(1, 0, At, B0); PG8_BAR; PG8_SCHED;
            PG8_STAGE(PG8_SB(1, 1), b3 + hstep, voffB);
            PG8_WAIT_V(6); PG8_BAR; PG8_MMA(1, 1, At, B1); PG8_BAR;
            }
        }
        if constexpr (ALIGN_EPI) { if (wr == 0) PG8_BAR; }
        if constexpr (!Epi::AFTER_DRAIN) { if constexpr (Epi::PRE) E(acc, cur, wr, wc, fr, fq, pre_); else E(acc, cur, wr, wc, fr, fq); S.done(cur); }
        if (!has_next) break;
#pragma unroll
        for (int a = 0; a < 2; ++a)
#pragma unroll
            for (int b = 0; b < 2; ++b)
#pragma unroll
                for (int m = 0; m < 4; ++m)
#pragma unroll
                    for (int n = 0; n < 2; ++n) acc[a][b][m][n] = (f32x4){0.f, 0.f, 0.f, 0.f};
        cur = nxt; cA = nA; cB = nB; ++ui;
        if constexpr (ALIGN_EPI) { if (wr == 1) PG8_BAR; }
    }
    PG8_WAIT_V(0);
    if constexpr (!ALIGN_EPI) { if (wr == 0) PG8_BAR; }
    PG8_BAR;
    if constexpr (Epi::AFTER_DRAIN) { E.fused(acc, cur, wr, wc, fr, fq, lds, wid, lane); S.done(cur); }
#undef PG8_SA
#undef PG8_SB
#undef PG8_STAGE
#undef PG8_LDA
#undef PG8_LDB
#undef PG8_MMA
#undef PG8_WAIT_V
#undef PG8_WAIT_L
#undef PG8_BAR
#undef PG8_SCHED
}
}


#ifndef NSA_NAIVE
#define NSA_NAIVE 0
#endif
#ifndef MEM_NAIVE
#define MEM_NAIVE 0
#endif
#ifndef FUSE_FINAL
#define FUSE_FINAL 1
#endif
#ifndef STAG_SLEEP
#define STAG_SLEEP 0
#endif
#ifndef REP_MIX
#define REP_MIX 1
#endif
#ifndef REP_INP
#define REP_INP 1
#endif
#ifndef REP_GU
#define REP_GU 1
#endif
#ifndef REP_MISC
#define REP_MISC 1
#endif
#ifndef REP_WIN
#define REP_WIN 1
#endif
#ifndef REP_TOPK
#define REP_TOPK 1
#endif
#ifndef REP_RES
#define REP_RES 1
#endif
#ifndef REP_SNSA
#define REP_SNSA 1
#endif
#ifndef REP_PNSA
#define REP_PNSA 1
#endif
#ifndef REP_PRO
#define REP_PRO 1
#endif
#ifndef MK_PER_PHASE
#define MK_PER_PHASE 0
#endif
constexpr int NWAVES = 8;

constexpr int D = 1024, BP = 4, TP = 4096, BS = 32, TS = 8, MP = BP * TP, MS = BS * TS, M = MP + MS;
constexpr int PAST = 8192, NPAGES = 64;
constexpr int CONV = 768, NMEM = 256, NINA = 2560, NINB = 1060, NINB_PAD = 1280, NKV = 1536, NB2 = NINB_PAD + NKV;
constexpr int FF = 2816, NGU = 2 * FF;
constexpr int NCP = 255, NCS = 511;
constexpr int CHP = 256, CHS = 512;
constexpr float RMS_EPS = 1e-6f;
#define NEG_INF (-__builtin_inff())

constexpr size_t OFF_YP = 0, OFF_YS = OFF_YP + (size_t)MP * D, OFF_CSP = OFF_YS + (size_t)MS * D, OFF_CSS = OFF_CSP + 2 * BP * 2 * CONV,
                 OFF_MEMKV = OFF_CSS + 2 * BS * 2 * CONV, OFF_CMP_P = OFF_MEMKV + (size_t)4 * BP * NMEM * 512, OFF_SLC_P = OFF_CMP_P + (size_t)MP * 512,
                 OFF_WIN_P = OFF_SLC_P + (size_t)MP * 512, OFF_CMP_S = OFF_WIN_P + (size_t)BP * 512 * 512, OFF_SLC_S = OFF_CMP_S + (size_t)MS * 512,
                 OFF_WIN_S = OFF_SLC_S + (size_t)MS * 512, OUT_TOTAL = OFF_WIN_S + (size_t)BS * 512 * 512;
static_assert(OUT_TOTAL == 45723648, "output size");

constexpr size_t MiB = 1u << 20;
constexpr size_t al1(size_t x) { return (x + MiB - 1) / MiB * MiB; }
constexpr size_t WS_CTL = 0, CTL_BYTES = 2 * MiB;
constexpr size_t WS_WINA = CTL_BYTES;
constexpr size_t WS_WINB2 = WS_WINA + al1((size_t)2 * NINA * D * 2);
constexpr size_t WS_WINB3 = WS_WINB2 + al1((size_t)NB2 * D * 2);
constexpr size_t WS_WO = WS_WINB3 + al1((size_t)NINB_PAD * D * 2);
constexpr size_t WS_WGU = WS_WO + al1((size_t)4 * D * D * 2);
constexpr size_t WS_WDN = WS_WGU + al1((size_t)4 * NGU * D * 2);
constexpr size_t WS_WMKV = WS_WDN + al1((size_t)4 * D * FF * 2);
constexpr size_t WS_XS = WS_WMKV + al1((size_t)2048 * D * 2);
constexpr size_t WS_IMPS = WS_XS, WS_IMPM = WS_XS + (size_t)256 * 8 * 24 * 64 * 16;
static_assert(WS_IMPM + (size_t)256 * 8 * 12 * 64 * 4 <= WS_XS + (size_t)M * D * 4, "importance scratch fits the region");
constexpr size_t WS_XB = WS_XS + al1((size_t)M * D * 4);
constexpr size_t WS_PROJ = WS_XB + al1((size_t)M * D * 2);
constexpr size_t WS_Y = WS_PROJ + al1((size_t)M * NINA * 2);
constexpr size_t WS_ACT = WS_Y + al1((size_t)M * D * 2);
constexpr size_t WS_KVB = WS_ACT + al1((size_t)M * FF * 2);
constexpr size_t WS_MEMB = WS_KVB + al1((size_t)M * NKV * 2);
constexpr size_t WS_HID = WS_MEMB + al1((size_t)1024 * D * 2);
constexpr size_t N_CHUNKS = (size_t)BP * CHP + (size_t)BS * CHS;
constexpr size_t WS_CK = WS_HID + al1(N_CHUNKS * 4 * 2 * 256 * 4);
constexpr size_t WS_MKB = WS_CK + al1(N_CHUNKS * 2 * 4 * 64 * 4);
constexpr size_t WS_MVT = WS_MKB + al1((size_t)4 * 1024 * 256 * 2);
constexpr size_t WS_VTB = WS_MVT + al1((size_t)4 * 1024 * 256 * 2);
constexpr size_t WS_KTB = WS_VTB + al1((size_t)2 * MP * 256 * 2);
constexpr size_t WS_CKB = WS_KTB + al1((size_t)2 * MP * 256 * 2);
constexpr size_t WS_CVT = WS_CKB + al1((size_t)BP * 4 * 256 * 64 * 2);
constexpr size_t WS_OACC = WS_CVT + al1((size_t)BP * 4 * 256 * 64 * 2);
constexpr size_t NR = N_CHUNKS * 4;
constexpr size_t WS_CMPA = WS_OACC + al1((size_t)256 * 8 * 24 * 64 * 16);
constexpr size_t WS_WCMP = WS_CMPA + al1((size_t)2 * NR * 1024 * 2);
constexpr size_t WS_CBIAS = WS_WCMP + al1((size_t)512 * 1024 * 2);
constexpr size_t WS_W2T = WS_CBIAS + (MiB >> 1);
constexpr size_t WS_HIDB = WS_CBIAS + MiB;
constexpr size_t WS_END = WS_HIDB + al1((size_t)2 * NR * 256 * 2);
static_assert(NR % 256 == 0 && NR / 256 == 272, "compression GEMM panels");
constexpr int CW_BAR = 1024, N_BAR_REGIONS = 1, CW_QUEUE = 512;
constexpr int CW_RS = 16384;
constexpr int CW_RSM = CW_RS + 9 * M;
static_assert((size_t)CW_RS * 4 + (size_t)(9 * M + 1024) * 8 <= CTL_BYTES && CW_BAR + 3456 <= CW_RS, "CTL map");

constexpr int LDS_BYTES = 147456;
constexpr int MISC_OFF = LDS_BYTES - 128;

#define GAS __attribute__((address_space(1)))
#define LAS __attribute__((address_space(3)))
typedef unsigned short bf16;
typedef unsigned v4u __attribute__((ext_vector_type(4)));
typedef unsigned v2u __attribute__((ext_vector_type(2)));
typedef float f32x4 __attribute__((ext_vector_type(4)));
typedef short bf16x8 __attribute__((ext_vector_type(8)));
typedef GAS unsigned gu32;
#define LDS_WAIT() asm volatile("s_waitcnt lgkmcnt(0)" ::: "memory")
__device__ __forceinline__ unsigned f2bf(float f) { unsigned u = __builtin_bit_cast(unsigned, f); return (u + 0x7fffu + ((u >> 16) & 1u)) >> 16; }
__device__ __forceinline__ unsigned pk2(float lo, float hi) { return f2bf(lo) | (f2bf(hi) << 16); }
__device__ __forceinline__ float bf2f(unsigned b) { return __builtin_bit_cast(float, b << 16); }
__device__ __forceinline__ float bflo(unsigned w) { return __builtin_bit_cast(float, w << 16); }
__device__ __forceinline__ float bfhi(unsigned w) { return __builtin_bit_cast(float, w & 0xffff0000u); }
__device__ __forceinline__ float wave_sum(float v) {
#pragma unroll
    for (int o = 1; o < 64; o <<= 1) v += __shfl_xor(v, o);
    return v;
}
__device__ __forceinline__ float wave_max(float v) {
#pragma unroll
    for (int o = 1; o < 64; o <<= 1) v = fmaxf(v, __shfl_xor(v, o));
    return v;
}
typedef unsigned long long u64;
__device__ __forceinline__ u64 to_fx(float s) { return (u64)(s * 1048576.f + 0.5f); }
__device__ __forceinline__ float from_fx(u64 v) { return (float)v * (1.f / 1048576.f); }
__device__ __forceinline__ int lane_id() { int l; asm volatile("v_mbcnt_lo_u32_b32 %0, -1, 0\n\tv_mbcnt_hi_u32_b32 %0, -1, %0" : "=v"(l)); return l; }
__device__ __forceinline__ float sigmoidf_(float x) { return __builtin_amdgcn_rcpf(1.f + __builtin_amdgcn_exp2f(x * -1.4426950408889634f)); }
typedef float f32x16 __attribute__((ext_vector_type(16)));
typedef __bf16 bf16x2_t __attribute__((ext_vector_type(2)));
typedef float f32x2_t __attribute__((ext_vector_type(2)));
#define LOG2E 1.4426950408889634f
#define MFMA32(a, b, c) __builtin_amdgcn_mfma_f32_32x32x16_bf16((a), (b), (c), 0, 0, 0)
__device__ __forceinline__ unsigned cvtpk(float lo, float hi) { f32x2_t v = {lo, hi}; return __builtin_bit_cast(unsigned, __builtin_convertvector(v, bf16x2_t)); }
__device__ __forceinline__ int vpermk(int kk) { return (kk & ~12) | ((kk & 4) << 1) | ((kk & 8) >> 1); }
constexpr int KP = 72;
__device__ __forceinline__ void zero16(f32x16& v) {
#pragma unroll
    for (int i = 0; i < 16; ++i) v[i] = 0.f;
}
__device__ __forceinline__ v4u pack8(const f32x4& v0, const f32x4& v1) { v4u w; w.x = pg8::cvt_pk_bf16(v0[0], v0[1]); w.y = pg8::cvt_pk_bf16(v0[2], v0[3]); w.z = pg8::cvt_pk_bf16(v1[0], v1[1]); w.w = pg8::cvt_pk_bf16(v1[2], v1[3]); return w; }


#define XB_TMO      128
#define XB_XCNT(j)  (256  + 64 * (j))
#define XB_XSUB(j)  (1280 + 64 * (j))
#define XB_XGEN(j)  (2304 + 64 * (j))
#define XB_TOP      3328
#define XB_TOPGEN   3392
#define XCD_BAR_WORDS 3456
#define XB_SPIN_CAP (1u << 20)

__device__ __forceinline__ unsigned xb_ld(unsigned* p)              { return __hip_atomic_load(p, __ATOMIC_RELAXED, __HIP_MEMORY_SCOPE_AGENT); }
__device__ __forceinline__ unsigned xb_add(unsigned* p, unsigned v) { return __hip_atomic_fetch_add(p, v, __ATOMIC_RELAXED, __HIP_MEMORY_SCOPE_AGENT); }
__device__ __forceinline__ unsigned xb_xcc_id() { return (unsigned)__builtin_amdgcn_s_getreg((3 << 11) | 20) & 0xFu; }
#define XB_SPIN(cond, bar) do { unsigned _sp = 0; while (cond) { __builtin_amdgcn_s_sleep(1); \
    if ((++_sp & 255u) == 0u) { if (xb_ld(&(bar)[XB_TMO])) break; if (_sp > XB_SPIN_CAP) { atomicAdd(&(bar)[XB_TMO], 1u); break; } } } } while (0)

struct XcdBarrier {
    unsigned* bar; unsigned x; int tid;
    volatile LAS unsigned* st;
};

__device__ __forceinline__ XcdBarrier xcd_barrier_post(unsigned* bar, volatile LAS unsigned* st, int tid) {
    XcdBarrier b; b.bar = bar; b.x = xb_xcc_id(); b.st = st; b.tid = tid;
    if (tid == 0) (void)xb_add(&bar[XB_XCNT(b.x)], 1u);
    return b;
}
__device__ __forceinline__ void xcd_barrier_complete(unsigned* bar, unsigned x, unsigned& nloc, unsigned& nx) {
    const unsigned G = gridDim.x * gridDim.y * gridDim.z;
    unsigned sum, cnt, mine, sp = 0u;
    for (;;) {
        sum = 0u; cnt = 0u; mine = 0u;
#pragma unroll
        for (unsigned j = 0; j < 16; ++j) { const unsigned c = xb_ld(&bar[XB_XCNT(j)]); sum += c; cnt += (c > 0u) ? 1u : 0u; mine = (j == x) ? c : mine; }
        if (sum == G) break;
        __builtin_amdgcn_s_sleep(1);
        if ((++sp & 255u) == 0u) { if (xb_ld(&bar[XB_TMO])) break; if (sp > XB_SPIN_CAP) { atomicAdd(&bar[XB_TMO], 1u); break; } }
    }
    nloc = mine > 0u ? mine : 1u; nx = cnt > 0u ? cnt : 1u;
}

__device__ __forceinline__ void xcd_barrier(const XcdBarrier& b) {
    asm volatile("s_waitcnt vmcnt(0)" ::: "memory");
    __syncthreads();
    if (b.tid == 0) {
        unsigned* bar = b.bar;
        __builtin_amdgcn_s_waitcnt(0);
        unsigned nloc = b.st[0], nx = b.st[1];
        if (nloc == 0u) { xcd_barrier_complete(bar, b.x, nloc, nx); b.st[0] = nloc; b.st[1] = nx; }
        const unsigned old = xb_add(&bar[XB_XSUB(b.x)], 1u);
        const unsigned gen = old / nloc;
        if (old + 1u == (gen + 1u) * nloc) {
            __builtin_amdgcn_fence(__ATOMIC_RELEASE, "agent");
            asm volatile("s_waitcnt vmcnt(0)" ::: "memory");
            const unsigned og = xb_add(&bar[XB_TOP], 1u);
            const unsigned tg = og / nx;
            if (og + 1u == (tg + 1u) * nx) xb_add(&bar[XB_TOPGEN], 1u);
            else XB_SPIN(xb_ld(&bar[XB_TOPGEN]) == tg, bar);
            __builtin_amdgcn_fence(__ATOMIC_ACQUIRE, "agent");
            xb_add(&bar[XB_XGEN(b.x)], 1u);
            asm volatile("s_waitcnt vmcnt(0)" ::: "memory");
        } else {
            XB_SPIN(xb_ld(&bar[XB_XGEN(b.x)]) == gen, bar);
            __builtin_amdgcn_fence(__ATOMIC_ACQUIRE, "agent");
            asm volatile("s_waitcnt vmcnt(0)" ::: "memory");
        }
    }
    __syncthreads();
}


struct Args { const void* in[28]; float* out; unsigned char* ws; int ph_lo, ph_hi, li, pad; };
typedef const __attribute__((address_space(4))) Args* KArgs;
struct Frame {
    KArgs ka;
    LAS unsigned char* lds;
    int tid, lane, wave, vcu, G;
    float* out; unsigned char* ws;
    const float *x_prompt, *x_sample, *state_conv, *cache_mem, *cache_cmp, *cache_slc, *state_win, *mem_prompt;
    const int* page_table;
    unsigned long long* rs;
    float* XS; bf16 *XB, *PROJ, *Y, *ACT, *KVB, *MEMB;
    float *HID, *CK;
};
constexpr int NPH = 2 + 7 * 4 + 1;
__device__ __forceinline__ Frame mkframe(LAS unsigned char* lds, int wv) {
    Frame F;
    KArgs ka = (KArgs)__builtin_amdgcn_kernarg_segment_ptr(); asm volatile("" : "+s"(ka));
    F.ka = ka; F.lds = lds;
    F.lane = lane_id();
    F.wave = wv; F.tid = wv * 64 + F.lane;
    F.G = gridDim.x; { const int bx = blockIdx.x; F.vcu = (F.G % 8 == 0) ? (bx % 8) * (F.G / 8) + bx / 8 : bx; }
    unsigned char* ws = ka->ws;
    F.out = ka->out; F.ws = ws;
    F.x_prompt = (const float*)ka->in[0]; F.x_sample = (const float*)ka->in[1]; F.state_conv = (const float*)ka->in[2]; F.cache_mem = (const float*)ka->in[3];
    F.cache_cmp = (const float*)ka->in[4]; F.cache_slc = (const float*)ka->in[5]; F.state_win = (const float*)ka->in[6]; F.page_table = (const int*)ka->in[7]; F.mem_prompt = (const float*)ka->in[8];
    F.rs = (unsigned long long*)((float*)(ws + WS_CTL) + CW_RS);
    F.XS = (float*)(ws + WS_XS); F.XB = (bf16*)(ws + WS_XB); F.PROJ = (bf16*)(ws + WS_PROJ); F.Y = (bf16*)(ws + WS_Y); F.ACT = (bf16*)(ws + WS_ACT);
    F.KVB = (bf16*)(ws + WS_KVB); F.MEMB = (bf16*)(ws + WS_MEMB); F.HID = (float*)(ws + WS_HID); F.CK = (float*)(ws + WS_CK);
    return F;
}

__device__ __forceinline__ void tr_tile(const float* W, int N, int K, int k0, int n0, const float* gain, bf16* WT, int drow0, LAS float* scr, int lane) {
    const int kq = lane >> 3, n4 = (lane & 7) * 4; const bool ok = n0 + n4 < N;
    f32x4 v[8]; float gs[8];
#pragma unroll
    for (int i = 0; i < 8; ++i) { const int kk = kq + 8 * i; v[i] = ok ? *(const f32x4*)(W + (size_t)(k0 + kk) * N + n0 + n4) : (f32x4){0.f, 0.f, 0.f, 0.f}; gs[i] = gain ? gain[k0 + kk] : 1.f; }
    __builtin_amdgcn_sched_barrier(0);
#pragma unroll
    for (int i = 0; i < 8; ++i) { const int kk = kq + 8 * i; const f32x4 x = v[i] * gs[i];
        LAS float* s = scr + kk * 33 + n4; s[0] = x.x; s[1] = x.y; s[2] = x.z; s[3] = x.w; }
    LDS_WAIT(); asm volatile("" ::: "memory");
    const int c = lane & 7;
#pragma unroll
    for (int j = 0; j < 4; ++j) { const int n = (lane >> 3) + 8 * j; const LAS float* s = scr + (8 * c) * 33 + n;
        v4u o; o.x = pk2(s[0 * 33], s[1 * 33]); o.y = pk2(s[2 * 33], s[3 * 33]); o.z = pk2(s[4 * 33], s[5 * 33]); o.w = pk2(s[6 * 33], s[7 * 33]);
        *(v4u*)(WT + (size_t)(drow0 + n) * K + k0 + 8 * c) = o; }
    LDS_WAIT(); asm volatile("" ::: "memory");
}
__device__ __forceinline__ bool tr_mat(int& it, const float* W, int K, int N, const float* gain, bf16* WT, int mode  , int off, LAS float* scr, int lane) {
    const int nblk = (N + 31) / 32, items = (K / 64) * nblk;
    if (it >= items) { it -= items; return false; }
    const int kb = it / nblk, nb = it % nblk, n0 = nb * 32;
    int drow0 = n0 + off;
    if (mode == 1) { const int up = n0 >= FF, j = up ? n0 - FF : n0; drow0 = (j / 128) * 256 + (up ? 128 : 0) + (j % 128); }
    tr_tile(W, N, K, kb * 64, n0, gain, WT, drow0, scr, lane);
    return true;
}
__device__ __forceinline__ void prologue(Frame& F) {
    LAS float* scr = (LAS float*)(F.lds + F.wave * 16384);
    const int gw = F.vcu * NWAVES + F.wave, NGW = F.G * NWAVES, lane = F.lane;
    const float* g_mix = (const float*)F.ka->in[9]; const float* w_in_a = (const float*)F.ka->in[10]; const float* w_in_b = (const float*)F.ka->in[12]; const float* w_o = (const float*)F.ka->in[13];
    const float* w_mkv = (const float*)F.ka->in[14]; const float* g_mem = (const float*)F.ka->in[15]; const float* g_kv = (const float*)F.ka->in[16]; const float* w_kv = (const float*)F.ka->in[17];
    const float* g_ffn = (const float*)F.ka->in[24]; const float* w_gu = (const float*)F.ka->in[25]; const float* w_dn = (const float*)F.ka->in[26];
    const float* pe_[2] = {(const float*)F.ka->in[18], (const float*)F.ka->in[21]}; const float* w1_[2] = {(const float*)F.ka->in[19], (const float*)F.ka->in[22]};
    constexpr int NITEMS = 2 * 16 * 80 + 16 * 34 + 16 * 48 + 3 * 16 * 32 + 3 * 16 * 176 + 3 * 44 * 32 + 4 * 16 * 16 + 4 * 16 * 4 + 2 * 2 * 2;
    for (int item = gw; item < NITEMS; item += NGW) {
        int it = item; bool done = false;
        for (int l = 0; l < 2 && !done; ++l) done = tr_mat(it, w_in_a + (size_t)l * D * NINA, D, NINA, g_mix + l * D, (bf16*)(F.ws + WS_WINA) + (size_t)l * NINA * D, 0, 0, scr, lane);
        if (!done) done = tr_mat(it, w_in_b, D, NINB, g_mix + 2 * D, (bf16*)(F.ws + WS_WINB2), 0, 0, scr, lane);
        if (!done) done = tr_mat(it, w_kv, D, NKV, g_kv, (bf16*)(F.ws + WS_WINB2), 0, NINB_PAD, scr, lane);
        for (int l = 0; l < 3 && !done; ++l) done = tr_mat(it, w_o + (size_t)l * D * D, D, D, nullptr, (bf16*)(F.ws + WS_WO) + (size_t)l * D * D, 0, 0, scr, lane);
        for (int l = 0; l < 3 && !done; ++l) done = tr_mat(it, w_gu + (size_t)l * D * NGU, D, NGU, g_ffn + l * D, (bf16*)(F.ws + WS_WGU) + (size_t)l * NGU * D, 1, 0, scr, lane);
        for (int l = 0; l < 3 && !done; ++l) done = tr_mat(it, w_dn + (size_t)l * FF * D, FF, D, nullptr, (bf16*)(F.ws + WS_WDN) + (size_t)l * D * FF, 0, 0, scr, lane);
        for (int l = 0; l < 4 && !done; ++l) done = tr_mat(it, w_mkv + (size_t)l * D * 512, D, 512, g_mem, (bf16*)(F.ws + WS_WMKV), 0, l * 512, scr, lane);
        for (int q = 0; q < 4 && !done; ++q) done = tr_mat(it, (const float*)((q >> 1) ? F.ka->in[22] : F.ka->in[19]) + (size_t)(q & 1) * 1024 * 128, 1024, 128, nullptr, (bf16*)(F.ws + WS_WCMP), 0, q * 128, scr, lane);
        for (int q = 0; q < 2 && !done; ++q) done = tr_mat(it, (const float*)(q ? F.ka->in[23] : F.ka->in[20]), 128, 64, nullptr, (bf16*)(F.ws + WS_W2T) + (size_t)q * 64 * 128, 0, 0, scr, lane);
    }
    for (int o = gw; o < 512; o += NGW) { const int kv = o >> 8, half = (o >> 7) & 1, e = o & 127; float s = 0.f;
        for (int i = lane; i < 1024; i += 64) s += pe_[kv][half * 1024 + i] * w1_[kv][((size_t)half * 1024 + i) * 128 + e];
        s = wave_sum(s); if (lane == 0) ((float*)(F.ws + WS_CBIAS))[o] = s; }
    for (int r = gw; r < 2 * 192; r += NGW) { bf16* base = (bf16*)(F.ws + (r < 192 ? WS_WINB2 : WS_WINB3)) + (size_t)(1088 + (r % 192)) * D;
        *(v4u*)(base + lane * 16) = (v4u){0, 0, 0, 0}; *(v4u*)(base + lane * 16 + 8) = (v4u){0, 0, 0, 0}; }
    for (int r = gw; r < M + 1024; r += NGW) {
        const float* src = r < MP ? F.x_prompt + (size_t)r * D : (r < M ? F.x_sample + (size_t)(r - MP) * D : F.mem_prompt + (size_t)(r - M) * D);
        float ss = 0.f; f32x4 xv[4];
#pragma unroll
        for (int j = 0; j < 4; ++j) xv[j] = *(const f32x4*)(src + j * 256 + lane * 4);
        __builtin_amdgcn_sched_barrier(0);
#pragma unroll
        for (int j = 0; j < 4; ++j) { const f32x4 v = xv[j]; ss += v.x * v.x + v.y * v.y + v.z * v.z + v.w * v.w;
            v2u o; o.x = pk2(v.x, v.y); o.y = pk2(v.z, v.w);
            if (r < M) *(v2u*)(F.XB + (size_t)r * D + j * 256 + lane * 4) = o;
            else *(v2u*)(F.MEMB + (size_t)(r - M) * D + j * 256 + lane * 4) = o; }
        ss = wave_sum(ss);
        if (lane == 0) { if (r < M) F.rs[r] = to_fx(ss); else F.rs[9 * M + (r - M)] = to_fx(ss); }
    }
}

__device__ __forceinline__ void l3_weights_phase(Frame& F) {
    LAS float* scr = (LAS float*)(F.lds + F.wave * 16384);
    const int lane = F.lane;
    const float* g_mix = (const float*)F.ka->in[9]; const float* w_in_b = (const float*)F.ka->in[12]; const float* w_o = (const float*)F.ka->in[13];
    const float* g_ffn = (const float*)F.ka->in[24]; const float* w_gu = (const float*)F.ka->in[25]; const float* w_dn = (const float*)F.ka->in[26];
    constexpr int NIT3 = 16 * 34 + 16 * 32 + 16 * 176 + 44 * 32;
    __syncthreads();
    if ((int)blockIdx.x >= 32 && F.G > 32)
    for (int item = ((int)blockIdx.x - 32) * NWAVES + F.wave; item < NIT3; item += (F.G - 32) * NWAVES) { int it = item; bool done = false;
        done = tr_mat(it, w_in_b + (size_t)D * NINB, D, NINB, g_mix + 3 * D, (bf16*)(F.ws + WS_WINB3), 0, 0, scr, lane);
        if (!done) done = tr_mat(it, w_o + (size_t)3 * D * D, D, D, nullptr, (bf16*)(F.ws + WS_WO) + (size_t)3 * D * D, 0, 0, scr, lane);
        if (!done) done = tr_mat(it, w_gu + (size_t)3 * D * NGU, D, NGU, g_ffn + 3 * D, (bf16*)(F.ws + WS_WGU) + (size_t)3 * NGU * D, 1, 0, scr, lane);
        if (!done) done = tr_mat(it, w_dn + (size_t)3 * FF * D, FF, D, nullptr, (bf16*)(F.ws + WS_WDN) + (size_t)3 * D * FF, 0, 0, scr, lane); }
    __syncthreads();
}

__device__ __forceinline__ void win_copy_phase(Frame& F) {
    const int gw = F.vcu * NWAVES + F.wave, NGW = F.G * NWAVES, lane = F.lane;
    for (int r = gw; r < BS * 504; r += NGW) { const int b = r / 504, i = r % 504;
        const float* src = F.state_win + ((size_t)b * 512 + i + 8) * 512; float* dst = F.out + OFF_WIN_S + ((size_t)b * 512 + i) * 512;
        *(f32x4*)(dst + lane * 8) = *(const f32x4*)(src + lane * 8); *(f32x4*)(dst + lane * 8 + 4) = *(const f32x4*)(src + lane * 8 + 4); }
}

#define EPI_ROWS(u) const int row0 = (u).pm * 256 + wr * 64 + fr

struct EpiMemKV {
    static constexpr bool PERM = true, AFTER_DRAIN = false, PRE = false;
    float* out; const u64* rsm; bf16* MKB; bf16* MVT;
    __device__ __forceinline__ void operator()(const f32x4 (&acc)[2][2][4][2], const pg8::Unit& u, int wr, int wc, int fr, int fq) const {
        EPI_ROWS(u);
        float rst_[2][4];
#pragma unroll
        for (int ai = 0; ai < 2; ++ai)
#pragma unroll
            for (int m = 0; m < 4; ++m) rst_[ai][m] = from_fx(rsm[row0 + ai * 128 + m * 16]);
#pragma unroll
        for (int ai = 0; ai < 2; ++ai)
#pragma unroll
            for (int m = 0; m < 4; ++m) rst_[ai][m] = rsqrtf(rst_[ai][m] * (1.f / D) + RMS_EPS);
#pragma unroll
        for (int ai = 0; ai < 2; ++ai)
#pragma unroll
            for (int m = 0; m < 4; ++m) { const int r = row0 + ai * 128 + m * 16; const float rstd = rst_[ai][m];
#pragma unroll
                for (int bj = 0; bj < 2; ++bj) { const int c = u.pn * 256 + bj * 128 + wc * 32 + 8 * fq; const int l = c >> 9, e = c & 511;
                    float* dst = out + OFF_MEMKV + (size_t)l * (BP * NMEM * 512) + (size_t)r * 512 + e;
                    const f32x4 v0 = acc[ai][bj][m][0] * rstd, v1 = acc[ai][bj][m][1] * rstd;
                    *(f32x4*)dst = v0; *(f32x4*)(dst + 4) = v1;
                    if (e < 256) *(v4u*)(MKB + ((size_t)l * 1024 + r) * 256 + e) = pack8(v0, v1);
                    else { const int hh = (e - 256) >> 6, d0 = (e - 256) & 63, b = r >> 8, mp = vpermk(r & 255);
                        bf16* vt = MVT + ((((size_t)l * 4 + b) * 4 + hh) * 64 + d0) * 256 + mp;
#pragma unroll
                        for (int i = 0; i < 4; ++i) { vt[(size_t)i * 256] = (bf16)f2bf(v0[i]); vt[(size_t)(i + 4) * 256] = (bf16)f2bf(v1[i]); } } } }
    }
};
struct EpiInA {
    static constexpr bool PERM = true, AFTER_DRAIN = false, PRE = true;
    bf16* O; int ld; const u64* rsq;
    __device__ __forceinline__ void pre(const pg8::Unit& u, int wr, int fr, u64 (&q)[8]) const { EPI_ROWS(u);
#pragma unroll
        for (int i = 0; i < 8; ++i) q[i] = rsq[row0 + (i >> 2) * 128 + (i & 3) * 16]; }
    __device__ __forceinline__ void operator()(const f32x4 (&acc)[2][2][4][2], const pg8::Unit& u, int wr, int wc, int fr, int fq, const u64 (&q)[8]) const {
        EPI_ROWS(u); const int col0 = u.pn * 256 + wc * 32 + 8 * fq;
        float rst_[2][4];
#pragma unroll
        for (int ai = 0; ai < 2; ++ai)
#pragma unroll
            for (int m = 0; m < 4; ++m) rst_[ai][m] = from_fx(q[ai * 4 + m]);
#pragma unroll
        for (int ai = 0; ai < 2; ++ai)
#pragma unroll
            for (int m = 0; m < 4; ++m) rst_[ai][m] = rsqrtf(rst_[ai][m] * (1.f / D) + RMS_EPS);
#pragma unroll
        for (int ai = 0; ai < 2; ++ai)
#pragma unroll
            for (int m = 0; m < 4; ++m) { const int r = row0 + ai * 128 + m * 16; const float rstd = rst_[ai][m];
#pragma unroll
                for (int bj = 0; bj < 2; ++bj) *(v4u*)(O + (size_t)r * ld + col0 + bj * 128) = pack8(acc[ai][bj][m][0] * rstd, acc[ai][bj][m][1] * rstd); }
    }
};
struct EpiInB {
    static constexpr bool PERM = true, AFTER_DRAIN = false, PRE = true;
    bf16* O; bf16* KVB; float* out; const u64* rsq; bf16* VTB; bf16* CMPA; bf16* KTB;
    __device__ __forceinline__ void pre(const pg8::Unit& u, int wr, int fr, u64 (&q)[8]) const { EPI_ROWS(u);
#pragma unroll
        for (int i = 0; i < 8; ++i) q[i] = rsq[row0 + (i >> 2) * 128 + (i & 3) * 16]; }
    __device__ __forceinline__ void operator()(const f32x4 (&acc)[2][2][4][2], const pg8::Unit& u, int wr, int wc, int fr, int fq, const u64 (&q)[8]) const {
        EPI_ROWS(u);
        float rst_[2][4];
#pragma unroll
        for (int ai = 0; ai < 2; ++ai)
#pragma unroll
            for (int m = 0; m < 4; ++m) rst_[ai][m] = from_fx(q[ai * 4 + m]);
#pragma unroll
        for (int ai = 0; ai < 2; ++ai)
#pragma unroll
            for (int m = 0; m < 4; ++m) rst_[ai][m] = rsqrtf(rst_[ai][m] * (1.f / D) + RMS_EPS);
        if (u.pn < 5) {
            const int col0 = u.pn * 256 + wc * 32 + 8 * fq;
#pragma unroll
            for (int ai = 0; ai < 2; ++ai)
#pragma unroll
                for (int m = 0; m < 4; ++m) { const int r = row0 + ai * 128 + m * 16; const float rstd = rst_[ai][m];
#pragma unroll
                    for (int bj = 0; bj < 2; ++bj) *(v4u*)(O + (size_t)r * NINB_PAD + col0 + bj * 128) = pack8(acc[ai][bj][m][0] * rstd, acc[ai][bj][m][1] * rstd); }
        } else {
            const int kc = (u.pn - 5) * 256, br = kc >> 9, w0 = (kc & 511) + wc * 32 + 8 * fq;
#pragma unroll
            for (int ai = 0; ai < 2; ++ai)
#pragma unroll
                for (int m = 0; m < 4; ++m) { const int r = row0 + ai * 128 + m * 16; const float rstd = rst_[ai][m];
                    float* dst = nullptr;
                    if (r < MP) { const int b = r >> 12, t = r & 4095;
                        if (br == 0) dst = out + OFF_CMP_P + (size_t)r * 512; else if (br == 1) dst = out + OFF_SLC_P + (size_t)r * 512;
                        else if (t >= TP - 512) dst = out + OFF_WIN_P + ((size_t)b * 512 + (t - (TP - 512))) * 512; }
                    else { const int rs_ = r - MP, b = rs_ >> 3, t = rs_ & 7;
                        if (br == 0) dst = out + OFF_CMP_S + (size_t)rs_ * 512; else if (br == 1) dst = out + OFF_SLC_S + (size_t)rs_ * 512;
                        else dst = out + OFF_WIN_S + ((size_t)b * 512 + 504 + t) * 512; }
#pragma unroll
                    for (int bj = 0; bj < 2; ++bj) { const f32x4 v0 = acc[ai][bj][m][0] * rstd, v1 = acc[ai][bj][m][1] * rstd;
                        if (dst) { *(f32x4*)(dst + w0 + bj * 128) = v0; *(f32x4*)(dst + w0 + bj * 128 + 4) = v1; }
                        const int wi = w0 + bj * 128;
                        if (br == 0 && r < MP) { const int kv = wi >> 8, kvh = (wi >> 6) & 3, d0 = wi & 63, b = r >> 12, t_ = r & 4095;
                            *(v4u*)(CMPA + ((size_t)kv * NR + ((size_t)b * CHP + (t_ >> 4)) * 4 + kvh) * 1024 + (t_ & 15) * 64 + d0) = pack8(v0, v1); }
                        if (br >= 1 && r < MP) { const int kvh = (wi >> 6) & 3, d0 = wi & 63, b = r >> 12, t_ = r & 4095;
                            if (wi < 256) *(v4u*)(KTB + (((((size_t)(br - 1) * 4 + b) * 4 + kvh) << 12) + t_) * 64 + d0) = pack8(v0, v1);
                            else { bf16* vt = VTB + ((((((size_t)(br - 1) * 4 + b) * 4 + kvh) * 64 + (t_ >> 6)) * 64 + d0) << 6) + vpermk(t_ & 63);
#pragma unroll
                                for (int i = 0; i < 4; ++i) { vt[i << 6] = (bf16)f2bf(v0[i]); vt[(i + 4) << 6] = (bf16)f2bf(v1[i]); } } } } }
        }
    }
};
struct EpiRes {
    static constexpr bool PERM = true, AFTER_DRAIN = false, PRE = false;
    bf16* XB; u64* rsn;
    __device__ __forceinline__ void operator()(const f32x4 (&acc)[2][2][4][2], const pg8::Unit& u, int wr, int wc, int fr, int fq) const {
        EPI_ROWS(u); const int col0 = u.pn * 256 + wc * 32 + 8 * fq;
        v4u xv[2][4][2];
#pragma unroll
        for (int ai = 0; ai < 2; ++ai)
#pragma unroll
            for (int m = 0; m < 4; ++m)
#pragma unroll
                for (int bj = 0; bj < 2; ++bj) xv[ai][m][bj] = *(const v4u*)(XB + (size_t)(row0 + ai * 128 + m * 16) * D + col0 + bj * 128);
        __builtin_amdgcn_sched_barrier(0);
#pragma unroll
        for (int ai = 0; ai < 2; ++ai) {
#pragma unroll
            for (int m = 0; m < 4; ++m) { const int r = row0 + ai * 128 + m * 16; float ss = 0.f;
#pragma unroll
                for (int bj = 0; bj < 2; ++bj) { const v4u x = xv[ai][m][bj];
                    const f32x4 v0 = (f32x4){bflo(x.x), bfhi(x.x), bflo(x.y), bfhi(x.y)} + acc[ai][bj][m][0], v1 = (f32x4){bflo(x.z), bfhi(x.z), bflo(x.w), bfhi(x.w)} + acc[ai][bj][m][1];
                    *(v4u*)(XB + (size_t)r * D + col0 + bj * 128) = pack8(v0, v1);
                    ss += v0.x * v0.x + v0.y * v0.y + v0.z * v0.z + v0.w * v0.w + v1.x * v1.x + v1.y * v1.y + v1.z * v1.z + v1.w * v1.w; }
                ss += __shfl_xor(ss, 16); ss += __shfl_xor(ss, 32);
                if (fq == 0) atomicAdd(rsn + r, to_fx(ss)); }
        }
    }
};
constexpr int CW_FIN = 8192;
static_assert(CW_FIN + 64 * 80 <= CW_RS && CW_FIN >= CW_BAR + 3456, "final counters inside the control region");
__device__ __forceinline__ void fin_wait(unsigned* cnt, const unsigned need) {
    if (lane_id() == 0) { unsigned sp = 0; while (__hip_atomic_load(cnt, __ATOMIC_RELAXED, __HIP_MEMORY_SCOPE_AGENT) < need && ++sp < (1u << 22)) __builtin_amdgcn_s_sleep(1); }
    asm volatile("" ::: "memory");
}
struct EpiFinal {
    static constexpr bool PERM = true, AFTER_DRAIN = false, PRE = false;
    const bf16* XB; u64* rsn; float* out; const float* g; unsigned* cnt;
    __device__ __forceinline__ void operator()(const f32x4 (&acc)[2][2][4][2], const pg8::Unit& u, int wr, int wc, int fr, int fq) const {
        EPI_ROWS(u); const int col0 = u.pn * 256 + wc * 32 + 8 * fq;
        v4u xv[2][4][2];
#pragma unroll
        for (int ai = 0; ai < 2; ++ai)
#pragma unroll
            for (int m = 0; m < 4; ++m)
#pragma unroll
                for (int bj = 0; bj < 2; ++bj) xv[ai][m][bj] = *(const v4u*)(XB + (size_t)(row0 + ai * 128 + m * 16) * D + col0 + bj * 128);
        f32x4 gg[2][2];
#pragma unroll
        for (int bj = 0; bj < 2; ++bj) { gg[bj][0] = *(const f32x4*)(g + col0 + bj * 128); gg[bj][1] = *(const f32x4*)(g + col0 + bj * 128 + 4); }
        __builtin_amdgcn_sched_barrier(0);
        f32x4 x[2][4][2][2];
#pragma unroll
        for (int ai = 0; ai < 2; ++ai)
#pragma unroll
            for (int m = 0; m < 4; ++m) { const int r = row0 + ai * 128 + m * 16; float ss = 0.f;
#pragma unroll
                for (int bj = 0; bj < 2; ++bj) { const v4u o_ = xv[ai][m][bj];
                    const f32x4 v0 = (f32x4){bflo(o_.x), bfhi(o_.x), bflo(o_.y), bfhi(o_.y)} + acc[ai][bj][m][0], v1 = (f32x4){bflo(o_.z), bfhi(o_.z), bflo(o_.w), bfhi(o_.w)} + acc[ai][bj][m][1];
                    x[ai][m][bj][0] = v0; x[ai][m][bj][1] = v1;
                    ss += v0.x * v0.x + v0.y * v0.y + v0.z * v0.z + v0.w * v0.w + v1.x * v1.x + v1.y * v1.y + v1.z * v1.z + v1.w * v1.w; }
                ss += __shfl_xor(ss, 16); ss += __shfl_xor(ss, 32);
                if (fq == 0) atomicAdd(rsn + r, to_fx(ss)); }
        asm volatile("s_waitcnt vmcnt(0)" ::: "memory");
        unsigned* c_ = cnt + 64 * u.pm;
        if (lane_id() == 0) __hip_atomic_fetch_add(c_, 1u, __ATOMIC_RELAXED, __HIP_MEMORY_SCOPE_AGENT);
        fin_wait(c_, 32u);
        float rst_[2][4];
#pragma unroll
        for (int ai = 0; ai < 2; ++ai)
#pragma unroll
            for (int m = 0; m < 4; ++m) rst_[ai][m] = from_fx(__hip_atomic_load(rsn + row0 + ai * 128 + m * 16, __ATOMIC_RELAXED, __HIP_MEMORY_SCOPE_AGENT));
#pragma unroll
        for (int ai = 0; ai < 2; ++ai)
#pragma unroll
            for (int m = 0; m < 4; ++m) { const int r = row0 + ai * 128 + m * 16; const float rstd = rsqrtf(rst_[ai][m] * (1.f / D) + RMS_EPS);
                float* dst = out + OFF_YP + (size_t)r * D + col0;
#pragma unroll
                for (int bj = 0; bj < 2; ++bj) { *(f32x4*)(dst + bj * 128) = x[ai][m][bj][0] * rstd * gg[bj][0]; *(f32x4*)(dst + bj * 128 + 4) = x[ai][m][bj][1] * rstd * gg[bj][1]; } }
    }
};
struct EpiNull {
    static constexpr bool PERM = true, AFTER_DRAIN = false, PRE = false;
    __device__ __forceinline__ void operator()(const f32x4 (&acc)[2][2][4][2], const pg8::Unit& u, int wr, int wc, int fr, int fq) const { if (acc[0][0][0][0][0] == 1.2345e-33f) *(volatile int*)nullptr = 0; }
};
struct EpiGU {
    static constexpr bool PERM = true, AFTER_DRAIN = false, PRE = true;
    bf16* O; const u64* rsq;
    __device__ __forceinline__ void pre(const pg8::Unit& u, int wr, int fr, u64 (&q)[8]) const { EPI_ROWS(u);
#pragma unroll
        for (int i = 0; i < 8; ++i) q[i] = rsq[row0 + (i >> 2) * 128 + (i & 3) * 16]; }
    __device__ __forceinline__ void operator()(const f32x4 (&acc)[2][2][4][2], const pg8::Unit& u, int wr, int wc, int fr, int fq, const u64 (&q)[8]) const {
        EPI_ROWS(u); const int col0 = u.pn * 128 + wc * 32 + 8 * fq;
        float rst_[2][4];
#pragma unroll
        for (int ai = 0; ai < 2; ++ai)
#pragma unroll
            for (int m = 0; m < 4; ++m) rst_[ai][m] = from_fx(q[ai * 4 + m]);
#pragma unroll
        for (int ai = 0; ai < 2; ++ai)
#pragma unroll
            for (int m = 0; m < 4; ++m) rst_[ai][m] = rst_[ai][m] * (1.f / D) + RMS_EPS;
#pragma unroll
        for (int ai = 0; ai < 2; ++ai)
#pragma unroll
            for (int m = 0; m < 4; ++m) { const int r = row0 + ai * 128 + m * 16; const float iv = rst_[ai][m], c1 = rsqrtf(iv) * -1.4426950408889634f;
                f32x4 o[2];
#pragma unroll
                for (int n = 0; n < 2; ++n)
#pragma unroll
                    for (int c = 0; c < 4; c += 2) {
                        const f32x2_t g = {acc[ai][0][m][n][c], acc[ai][0][m][n][c + 1]}, up = {acc[ai][1][m][n][c], acc[ai][1][m][n][c + 1]};
                        const f32x2_t t = g * c1; const f32x2_t e = {__builtin_amdgcn_exp2f(t.x), __builtin_amdgcn_exp2f(t.y)};
                        const f32x2_t d = e * iv + iv; const f32x2_t rr = {__builtin_amdgcn_rcpf(d.x), __builtin_amdgcn_rcpf(d.y)};
                        const f32x2_t q = (g * up) * rr; o[n][c] = q.x; o[n][c + 1] = q.y; }
                *(v4u*)(O + (size_t)r * FF + col0) = pack8(o[0], o[1]); }
    }
};

struct CmpOrder {
    int p0, np, G, c;
    __device__ __forceinline__ bool next(int i, pg8::Unit& u) const { const long L = (long)i * G + c; if (L >= 2 * np) return false; const int kv = L >= np ? 1 : 0; u.pm = kv * (int)(NR / 256) + p0 + ((int)L - kv * np); u.pn = kv; return true; }
    __device__ __forceinline__ void a_ready(const pg8::Unit&) const {}
    __device__ __forceinline__ void done(const pg8::Unit&) const {}
};
struct EpiHid {
    static constexpr bool PERM = true, AFTER_DRAIN = false, PRE = false;
    bf16* O; const float* bias;
    __device__ __forceinline__ void operator()(const f32x4 (&acc)[2][2][4][2], const pg8::Unit& u, int wr, int wc, int fr, int fq) const {
        EPI_ROWS(u); const int col0 = wc * 32 + 8 * fq;
        f32x4 bv[2][2];
#pragma unroll
        for (int bj = 0; bj < 2; ++bj)
#pragma unroll
            for (int n = 0; n < 2; ++n) bv[bj][n] = *(const f32x4*)(bias + u.pn * 256 + bj * 128 + col0 + 4 * n);
#pragma unroll
        for (int ai = 0; ai < 2; ++ai)
#pragma unroll
            for (int m = 0; m < 4; ++m) { const int r = row0 + ai * 128 + m * 16;
#pragma unroll
                for (int bj = 0; bj < 2; ++bj) *(v4u*)(O + (size_t)r * 256 + col0 + bj * 128) = pack8(acc[ai][bj][m][0] + bv[bj][0], acc[ai][bj][m][1] + bv[bj][1]); }
    }
};


template <bool FINAL = false> __device__ __forceinline__ void sample_res_gemm(Frame& F, const bf16* A, int K, const bf16* Bt, u64* rsn, const float* g_final = nullptr) {
    const int lane = F.lane, w = F.wave, tid = F.tid, rw = lane & 15, quad = lane >> 4, kw = K >> 3, k0 = w * kw;
    LAS f32x4* red = (LAS f32x4*)F.lds; LAS u64* rsL = (LAS u64*)(F.lds + 32768);
    for (int unit = F.vcu; unit < 256; unit += F.G) {
        const int r0 = MP + 16 * (unit >> 4), n0 = 64 * (unit & 15);
        f32x4 acc[4];
#pragma unroll
        for (int nb = 0; nb < 4; ++nb) acc[nb] = (f32x4){0.f, 0.f, 0.f, 0.f};
        const bf16* ap = A + (size_t)(r0 + rw) * K + k0 + quad * 8; const bf16* bp = Bt + (size_t)(n0 + rw) * K + k0 + quad * 8;
        bf16 xo[4];
        { const int nbx = (tid >> 6) & 3, lnx = tid & 63;
#pragma unroll
          for (int j = 0; j < 4; ++j) xo[j] = ((const bf16*)(F.ws + WS_XB))[(size_t)(r0 + (lnx >> 4) * 4 + j) * D + n0 + 16 * nbx + (lnx & 15)]; }
        bf16x8 a[2][4], bq[2][4][4];
#define SRG_LOAD(buf, kk) do { _Pragma("unroll") for (int s = 0; s < 4; ++s) if ((kk) + 32 * s < kw) { a[buf][s] = *(const bf16x8*)(ap + (kk) + 32 * s); \
            _Pragma("unroll") for (int nb = 0; nb < 4; ++nb) bq[buf][s][nb] = *(const bf16x8*)(bp + (size_t)nb * 16 * K + (kk) + 32 * s); } } while (0)
#define SRG_MMA(buf, kk) do { _Pragma("unroll") for (int s = 0; s < 4; ++s) if ((kk) + 32 * s < kw) { \
            _Pragma("unroll") for (int nb = 0; nb < 4; ++nb) acc[nb] = __builtin_amdgcn_mfma_f32_16x16x32_bf16(a[buf][s], bq[buf][s][nb], acc[nb], 0, 0, 0); } } while (0)
        SRG_LOAD(0, 0);
        if (128 < kw) SRG_LOAD(1, 128);
        __builtin_amdgcn_sched_barrier(0);
        SRG_MMA(0, 0);
        if (256 < kw) SRG_LOAD(0, 256);
        __builtin_amdgcn_sched_barrier(0);
        if (128 < kw) SRG_MMA(1, 128);
        if (256 < kw) SRG_MMA(0, 256);
#undef SRG_LOAD
#undef SRG_MMA
        __syncthreads();
#pragma unroll
        for (int nb = 0; nb < 4; ++nb) red[(w * 4 + nb) * 64 + lane] = acc[nb];
        if (tid < 16) rsL[tid] = 0ull;
        __syncthreads();
        if (tid < 256) { const int nb = tid >> 6, ln = tid & 63; f32x4 s = red[nb * 64 + ln];
#pragma unroll
            for (int ww = 1; ww < 8; ++ww) s += red[(ww * 4 + nb) * 64 + ln];
#pragma unroll
            for (int j = 0; j < 4; ++j) { const int rl = (ln >> 4) * 4 + j; const size_t idx = (size_t)(r0 + rl) * D + n0 + 16 * nb + (ln & 15);
                const float x = bf2f(xo[j]) + s[j]; if (!FINAL) ((bf16*)(F.ws + WS_XB))[idx] = (bf16)f2bf(x); else s[j] = x;
                atomicAdd((u64*)(rsL + rl), to_fx(x * x)); }
            if (FINAL) red[tid] = s; }
        __syncthreads();
        if (tid < 16) atomicAdd(rsn + r0 + tid, (u64)rsL[tid]);
        if (FINAL) {
            LAS float* rstL = (LAS float*)(F.lds + 32768 + 256);
            if (w == 0) { asm volatile("s_waitcnt vmcnt(0)" ::: "memory");
                unsigned* c_ = (unsigned*)(F.ws + WS_CTL) + CW_FIN + 64 * (64 + (unit >> 4));
                if (lane_id() == 0) __hip_atomic_fetch_add(c_, 1u, __ATOMIC_RELAXED, __HIP_MEMORY_SCOPE_AGENT);
                fin_wait(c_, 16u);
                if (tid < 16) rstL[tid] = rsqrtf(from_fx(__hip_atomic_load(rsn + r0 + tid, __ATOMIC_RELAXED, __HIP_MEMORY_SCOPE_AGENT)) * (1.f / D) + RMS_EPS); }
            __syncthreads();
            if (tid < 256) { const int nb = tid >> 6, ln = tid & 63; const f32x4 xs = red[tid];
#pragma unroll
                for (int j = 0; j < 4; ++j) { const int rl = (ln >> 4) * 4 + j, col = n0 + 16 * nb + (ln & 15);
                    F.out[OFF_YS + (size_t)(r0 - MP + rl) * D + col] = xs[j] * rstL[rl] * g_final[col]; } } }
    }
    __syncthreads();
}

__device__ __forceinline__ void cmp_sample_fused_phase(Frame& F) {
    constexpr int BPI = 136;
    LAS bf16* Bs = (LAS bf16*)F.lds;
    const int w = F.wave;
    const bf16* WC = (const bf16*)(F.ws + WS_WCMP); const float* bias = (const float*)(F.ws + WS_CBIAS); bf16* HB = (bf16*)(F.ws + WS_HIDB);
    for (int unit = F.vcu; unit < 2 * BS * 8; unit += F.G) {
        const int lane = lane_id(), tid = w * 64 + lane, rw = lane & 15, quad = lane >> 4, kvh = rw & 3;
        const int kv = unit >> 8, b = (unit >> 3) & 31, cg = unit & 7, chunk0 = cg * 64 + 8 * w + (rw >> 2);
        const bf16* wsrc = WC + (size_t)(kv * 256) * 1024;
        f32x4 areg[2][4][2];
        const int pgw = __builtin_amdgcn_readfirstlane(F.page_table[b * NPAGES + cg * 8 + w]);
        const char* ubase = (const char*)(F.cache_cmp + ((size_t)pgw * 128) * 512 + kv * 256);
        unsigned loff = (unsigned)((((rw >> 2) * 16) * 512 + kvh * 64 + quad * 8) * 4); asm volatile("" : "+v"(loff));
#define CSF_FETCH1(kc, t, s) do { const char* p_ = ubase + (size_t)(((64 * (t) + 2 * (kc) + ((s) >> 1)) * 512 + ((s) & 1) * 32) * 4); \
            areg[t][s][0] = __builtin_nontemporal_load((const f32x4*)(p_ + loff)); areg[t][s][1] = __builtin_nontemporal_load((const f32x4*)(p_ + loff + 16)); } while (0)
        f32x4 acc[2][16];
#pragma unroll
        for (int nb = 0; nb < 16; ++nb) acc[0][nb] = *(const f32x4*)(bias + kv * 256 + nb * 16 + quad * 4);
        v4u breg[8];
#define CSF_BT(kc) do { unsigned tq = (unsigned)tid; asm volatile("" : "+v"(tq)); const char* wk = (const char*)(wsrc + (kc) * 128); \
            _Pragma("unroll") for (int it = 0; it < 8; ++it) { const unsigned i = tq + 512u * it; breg[it] = *(const v4u*)(wk + ((i >> 4) * 2048u + (i & 15u) * 16u)); } } while (0)
        CSF_BT(0);
#pragma unroll
        for (int t = 0; t < 2; ++t)
#pragma unroll
            for (int s = 0; s < 4; ++s) CSF_FETCH1(0, t, s);
        __builtin_amdgcn_sched_barrier(0);
#pragma unroll
        for (int nb = 0; nb < 16; ++nb) acc[1][nb] = acc[0][nb];
        for (int kc = 0; kc < 8; ++kc) {
            __syncthreads();
            { unsigned tq = (unsigned)tid; asm volatile("" : "+v"(tq));
#pragma unroll
              for (int it = 0; it < 8; ++it) { const unsigned i = tq + 512u * it; *(LAS v4u*)(Bs + (i >> 4) * BPI + (i & 15u) * 8u) = breg[it]; } }
            __syncthreads();
            if (kc < 7) CSF_BT(kc + 1);
            __builtin_amdgcn_sched_barrier(0);
#pragma unroll
            for (int s = 0; s < 4; ++s) {
                const bf16x8 a0 = __builtin_bit_cast(bf16x8, pack8(areg[0][s][0], areg[0][s][1])), a1 = __builtin_bit_cast(bf16x8, pack8(areg[1][s][0], areg[1][s][1]));
                if (kc < 7) { CSF_FETCH1(kc + 1, 0, s); CSF_FETCH1(kc + 1, 1, s); }
#pragma unroll
                for (int nb = 0; nb < 16; ++nb) { const bf16x8 bq = *(const LAS bf16x8*)(Bs + (nb * 16 + rw) * BPI + s * 32 + quad * 8);
                    acc[0][nb] = __builtin_amdgcn_mfma_f32_16x16x32_bf16(bq, a0, acc[0][nb], 0, 0, 0); acc[1][nb] = __builtin_amdgcn_mfma_f32_16x16x32_bf16(bq, a1, acc[1][nb], 0, 0, 0); }
                __builtin_amdgcn_sched_barrier(0); }
        }
#undef CSF_BT
        __builtin_amdgcn_sched_barrier(0);
#undef CSF_FETCH1
        { const int ln = lane_id(), rw2 = ln & 15, quad2 = ln >> 4;
#pragma unroll
          for (int t = 0; t < 2; ++t) { const size_t row = (size_t)kv * NR + ((size_t)BP * CHP + (size_t)b * CHS + cg * 64 + 8 * w + (rw2 >> 2) + 4 * t) * 4 + (rw2 & 3);
#pragma unroll
            for (int nb = 0; nb < 16; ++nb) { const f32x4 v = acc[t][nb];
                v2u o; o.x = cvtpk(v.x, v.y); o.y = cvtpk(v.z, v.w); *(v2u*)(HB + row * 256 + nb * 16 + quad2 * 4) = o; } } }
    }
    __syncthreads();
}

__device__ __forceinline__ void conv_phase(Frame& F, int l, const float* conv_w) {
    const int gw = F.vcu * NWAVES + F.wave, NGW = F.G * NWAVES, lane = F.lane;
    const float* cw = conv_w + (size_t)l * 3 * CONV;
    f32x4 w[3][3];
#pragma unroll
    for (int i = 0; i < 3; ++i)
#pragma unroll
        for (int kk = 0; kk < 3; ++kk) w[i][kk] = *(const f32x4*)(cw + kk * CONV + 256 * i + 4 * lane);
    for (int pass = 0; pass < 2; ++pass)
    for (int v = pass == 0 ? gw : NGW - 1 - gw; v < (pass == 0 ? MP / 8 : MS); v += NGW) {
        if (pass == 1 && (v & 7)) continue;
        const int seg = pass == 0 ? v : MP / 8 + (v >> 3);
        const int r0 = seg * 8; const bool S = r0 >= MP; const int b = S ? (r0 - MP) >> 3 : r0 >> 12, t0 = S ? 0 : r0 & 4095, T = S ? TS : TP;
        float* cs = S ? F.out + OFF_CSS + ((size_t)l * BS + b) * 2 * CONV : F.out + OFF_CSP + ((size_t)l * BP + b) * 2 * CONV;
        f32x4 u1[3], u2[3];
        v2u in_[8][3][3];
#pragma unroll
        for (int j = 0; j < 8; ++j) { const bf16* pr = F.PROJ + (size_t)(r0 + j) * NINA;
#pragma unroll
            for (int i = 0; i < 3; ++i) { const int c0 = 256 * i + 4 * lane; in_[j][i][0] = *(const v2u*)(pr + c0); in_[j][i][1] = *(const v2u*)(pr + CONV + c0); in_[j][i][2] = *(const v2u*)(pr + 2 * CONV + c0); } }
#pragma unroll
        for (int i = 0; i < 3; ++i) { const int c0 = 256 * i + 4 * lane;
            if (S) { const float* st = F.state_conv + ((size_t)l * BS + b) * 2 * CONV; u2[i] = *(const f32x4*)(st + c0); u1[i] = *(const f32x4*)(st + CONV + c0); }
            else if (t0 == 0) { u1[i] = (f32x4){0.f, 0.f, 0.f, 0.f}; u2[i] = u1[i]; }
            else {
#pragma unroll
                for (int kk = 0; kk < 2; ++kk) { const bf16* pr = F.PROJ + (size_t)(r0 - 2 + kk) * NINA; const v2u cg = *(const v2u*)(pr + CONV + c0), hh = *(const v2u*)(pr + 2 * CONV + c0);
                    const f32x4 uu = {bflo(cg.x) * bflo(hh.x), bfhi(cg.x) * bfhi(hh.x), bflo(cg.y) * bflo(hh.y), bfhi(cg.y) * bfhi(hh.y)};
                    if (kk == 0) u2[i] = uu; else u1[i] = uu; } } }
        __builtin_amdgcn_sched_barrier(0);
#pragma unroll
        for (int j = 0; j < 8; ++j) { const int r = r0 + j, t = t0 + j;
#pragma unroll
            for (int i = 0; i < 3; ++i) { const int c0 = 256 * i + 4 * lane;
                const v2u bg = in_[j][i][0], cg = in_[j][i][1], hh = in_[j][i][2];
                const f32x4 uu = {bflo(cg.x) * bflo(hh.x), bfhi(cg.x) * bfhi(hh.x), bflo(cg.y) * bflo(hh.y), bfhi(cg.y) * bfhi(hh.y)};
                const f32x4 y = w[i][0] * u2[i] + w[i][1] * u1[i] + w[i][2] * uu;
                if (t >= T - 2) *(f32x4*)(cs + (size_t)(t - (T - 2)) * CONV + c0) = uu;
                v2u o; o.x = pk2(bflo(bg.x) * y.x, bfhi(bg.x) * y.y); o.y = pk2(bflo(bg.y) * y.z, bfhi(bg.y) * y.w);
                *(v2u*)(F.Y + (size_t)r * D + c0) = o;
                u2[i] = u1[i]; u1[i] = uu; } }
    }
}
__device__ __forceinline__ void memattn_phase(Frame& F, int l, int ldp, int qoff) {
    LAS float* Ks = (LAS float*)F.lds; LAS float* Vs = Ks + 256 * 65; LAS float* ps = Vs + 256 * 64 + F.wave * 256; LAS float* qs = Vs + 256 * 64 + 8 * 256 + F.wave * 64;
    const int lane = F.lane;
    constexpr int NU = BP * 4 * 16 + BS * 4;
    for (int u = F.vcu; u < NU; u += F.G) {
        int row0, nrows, h; const float* kv;
        if (u < BP * 4 * 16) { const int b = u >> 6, ch = u & 15; h = (u >> 4) & 3; row0 = b * TP + ch * 256; nrows = 256; kv = F.out + OFF_MEMKV + ((size_t)l * BP + b) * NMEM * 512; }
        else { const int v = u - BP * 4 * 16, b = v >> 2; h = v & 3; row0 = MP + b * TS; nrows = TS; kv = F.cache_mem + ((size_t)l * BS + b) * NMEM * 512; }
        __syncthreads();
        for (int i = F.tid; i < 256 * 16; i += 512) { const int m = i >> 4, d4 = (i & 15) * 4;
            const f32x4 k = *(const f32x4*)(kv + (size_t)m * 512 + h * 64 + d4), v = *(const f32x4*)(kv + (size_t)m * 512 + 256 + h * 64 + d4);
            Ks[m * 65 + d4] = k.x; Ks[m * 65 + d4 + 1] = k.y; Ks[m * 65 + d4 + 2] = k.z; Ks[m * 65 + d4 + 3] = k.w; *(LAS f32x4*)(Vs + m * 64 + d4) = v; }
        __syncthreads();
        for (int rr = F.wave; rr < nrows; rr += NWAVES) { const int r = row0 + rr;
            qs[lane] = bf2f(F.PROJ[(size_t)r * ldp + qoff + h * 64 + lane]) * 0.125f;
            LDS_WAIT();
            float s[4] = {0.f, 0.f, 0.f, 0.f};
            for (int d = 0; d < 64; ++d) { const float q = qs[d];
#pragma unroll
                for (int j = 0; j < 4; ++j) s[j] += q * Ks[(lane + 64 * j) * 65 + d]; }
            const float mx = wave_max(fmaxf(fmaxf(s[0], s[1]), fmaxf(s[2], s[3])));
            float p[4], sum = 0.f;
#pragma unroll
            for (int j = 0; j < 4; ++j) { p[j] = __expf(s[j] - mx); sum += p[j]; }
            const float inv = 1.f / wave_sum(sum);
#pragma unroll
            for (int j = 0; j < 4; ++j) ps[lane + 64 * j] = p[j] * inv;
            LDS_WAIT();
            float o = 0.f;
            for (int m = 0; m < 256; ++m) o += ps[m] * Vs[m * 64 + lane];
            F.Y[(size_t)r * D + CONV + h * 64 + lane] = (bf16)f2bf(o);
            LDS_WAIT(); }
    }
    __syncthreads();
}

__device__ __forceinline__ void ctx1_phase(Frame& F) {
    LAS float* rs = (LAS float*)F.lds;
    LAS float* pes = rs + 16384;
    const float* pe[2] = {(const float*)F.ka->in[18], (const float*)F.ka->in[21]}; const float* w1[2] = {(const float*)F.ka->in[19], (const float*)F.ka->in[22]};
    const int tid = F.tid, kvs = tid >> 8, o = tid & 255, half = o >> 7, e = o & 127;
    for (int i = tid; i < 4096; i += 512) pes[i] = pe[i >> 11][i & 2047];
    constexpr int NT = (BP * 32 + BS * 64) * 4;
    for (int task = F.vcu; task < NT; task += F.G) {
        const int kvh = task & 3, g = task >> 2; const bool S = g >= BP * 32; const int b = S ? (g - BP * 32) >> 6 : g >> 5, cg = S ? (g - BP * 32) & 63 : g & 31;
        __syncthreads();
        for (int i = tid; i < 2 * 8 * 16 * 16; i += 512) { const int d4 = (i & 15) * 4, j = (i >> 4) & 15, c = (i >> 8) & 7, kv = i >> 11; const int pos = (cg * 8 + c) * 16 + j;
            f32x4 v;
            if (!S) { const v2u w = *(const v2u*)(F.KVB + ((size_t)b * TP + pos) * NKV + kv * 256 + kvh * 64 + d4); v = (f32x4){bflo(w.x), bfhi(w.x), bflo(w.y), bfhi(w.y)}; }
            else { const int pg = F.page_table[b * NPAGES + (pos >> 7)]; v = *(const f32x4*)(F.cache_cmp + ((size_t)pg * 128 + (pos & 127)) * 512 + kv * 256 + kvh * 64 + d4); }
            *(LAS f32x4*)(rs + ((kv * 8 + c) * 16 + j) * 64 + d4) = v; }
        __syncthreads();
        float acc[8] = {0.f, 0.f, 0.f, 0.f, 0.f, 0.f, 0.f, 0.f}; float accb = 0.f;
        const float* w = w1[kvs] + (size_t)(half * 16) * 64 * 128 + e;
#pragma unroll 1
        for (int j = 0; j < 16; ++j)
#pragma unroll 2
            for (int d4 = 0; d4 < 64; d4 += 4) {
                const float w0 = w[(size_t)(j * 64 + d4) * 128], w1_ = w[(size_t)(j * 64 + d4 + 1) * 128], w2 = w[(size_t)(j * 64 + d4 + 2) * 128], w3 = w[(size_t)(j * 64 + d4 + 3) * 128];
                const f32x4 p4 = *(const LAS f32x4*)(pes + (kvs * 32 + half * 16 + j) * 64 + d4);
                accb += p4.x * w0 + p4.y * w1_ + p4.z * w2 + p4.w * w3;
#pragma unroll
                for (int c = 0; c < 8; ++c) { const f32x4 r4 = *(const LAS f32x4*)(rs + ((kvs * 8 + c) * 16 + j) * 64 + d4); acc[c] += r4.x * w0 + r4.y * w1_ + r4.z * w2 + r4.w * w3; } }
        const size_t ch0 = S ? (size_t)BP * CHP + (size_t)b * CHS + cg * 8 : (size_t)b * CHP + cg * 8;
#pragma unroll
        for (int c = 0; c < 8; ++c) F.HID[(((ch0 + c) * 4 + kvh) * 2 + kvs) * 256 + o] = acc[c] + accb;
    }
    __syncthreads();
}
__device__ __forceinline__ void ctx2_phase(Frame& F) {
    LAS float* hs = (LAS float*)F.lds + F.wave * 128;
    const float* w2[2] = {(const float*)F.ka->in[20], (const float*)F.ka->in[23]};
    const int gw = F.vcu * NWAVES + F.wave, NGW = F.G * NWAVES, lane = F.lane;
    constexpr int NT = (BP * NCP + BS * NCS) * 8;
    for (int task = gw; task < NT; task += NGW) {
        const int kv = task & 1, kvh = (task >> 1) & 3, g = task >> 3; const bool S = g >= BP * NCP;
        const int b = S ? (g - BP * NCP) / NCS : g / NCP, n = S ? (g - BP * NCP) % NCS : g % NCP;
        const size_t ch = S ? (size_t)BP * CHP + (size_t)b * CHS + n : (size_t)b * CHP + n;
        const bf16* hl = (const bf16*)(F.ws + WS_HIDB) + ((size_t)kv * NR + ch * 4 + kvh) * 256; const bf16* ht = (const bf16*)(F.ws + WS_HIDB) + ((size_t)kv * NR + (ch + 1) * 4 + kvh) * 256 + 128;
#pragma unroll
        for (int j = 0; j < 2; ++j) { const float x = bf2f(hl[lane + 64 * j]) + bf2f(ht[lane + 64 * j]); hs[lane + 64 * j] = x / (1.f + __expf(-x)); }
        LDS_WAIT();
        float o = 0.f; const float* w = w2[kv] + lane;
        for (int e = 0; e < 128; ++e) o += hs[e] * w[e * 64];
        F.CK[((ch * 2 + kv) * 4 + kvh) * 64 + lane] = o;
        if (!S) { if (kv == 0) ((bf16*)(F.ws + WS_CKB))[(((size_t)b * 4 + kvh) * 256 + n) * 64 + lane] = (bf16)f2bf(o);
                  else ((bf16*)(F.ws + WS_CVT))[(((size_t)b * 4 + kvh) * 64 + lane) * 256 + vpermk(n)] = (bf16)f2bf(o); }
        LDS_WAIT();
    }
}

__device__ __forceinline__ void ctx2_mfma_phase(Frame& F, const bool sample_part  ) {
    const int gw = F.vcu * NWAVES + F.wave, NGW = F.G * NWAVES, lane = F.lane, r = lane & 31, h = lane >> 5;
    const bf16* HB = (const bf16*)(F.ws + WS_HIDB);
    constexpr int TPH = (int)(NR / 32);
    constexpr int TPP = BP * CHP * 4 / 32, TPS = TPH - TPP;
    for (int it = gw; it < 2 * (sample_part ? TPS : TPP); it += NGW) {
        const int kv = it >= (sample_part ? TPS : TPP) ? 1 : 0, tile = sample_part ? (it - kv * TPS) + TPP + kv * TPH : (it - kv * TPP) + kv * TPH;
        const int rho = (tile - kv * TPH) * 32 + r, ch = rho >> 2, kvh = rho & 3;
        const bool S = ch >= BP * CHP; const int c = S ? (ch - BP * CHP) & (CHS - 1) : ch & (CHP - 1), b = S ? (ch - BP * CHP) >> 9 : ch >> 8;
        const bool valid = S ? c < CHS - 1 : c < CHP - 1;
        const size_t rl = (size_t)kv * NR + rho, rt = (size_t)kv * NR + (valid ? rho + 4 : rho);
        const bf16* W2T = (const bf16*)(F.ws + WS_W2T) + (size_t)kv * 64 * 128;
        f32x16 acc[2]; zero16(acc[0]); zero16(acc[1]);
#pragma unroll
        for (int s = 0; s < 8; ++s) { const int kk = 16 * s + 8 * h;
            const v4u a = *(const v4u*)(HB + rl * 256 + kk), t = *(const v4u*)(HB + rt * 256 + 128 + kk);
            float x[8]; x[0] = bflo(a.x) + bflo(t.x); x[1] = bfhi(a.x) + bfhi(t.x); x[2] = bflo(a.y) + bflo(t.y); x[3] = bfhi(a.y) + bfhi(t.y);
            x[4] = bflo(a.z) + bflo(t.z); x[5] = bfhi(a.z) + bfhi(t.z); x[6] = bflo(a.w) + bflo(t.w); x[7] = bfhi(a.w) + bfhi(t.w);
#pragma unroll
            for (int j = 0; j < 8; ++j) x[j] = x[j] * sigmoidf_(x[j]);
            v4u hb; hb.x = cvtpk(x[0], x[1]); hb.y = cvtpk(x[2], x[3]); hb.z = cvtpk(x[4], x[5]); hb.w = cvtpk(x[6], x[7]);
#pragma unroll
            for (int nb = 0; nb < 2; ++nb) acc[nb] = MFMA32(*(const bf16x8*)(W2T + (size_t)(nb * 32 + r) * 128 + kk), __builtin_bit_cast(bf16x8, hb), acc[nb]); }
        if (valid) {
#pragma unroll
            for (int nb = 0; nb < 2; ++nb)
#pragma unroll
                for (int a = 0; a < 4; ++a) { const int n = nb * 32 + 8 * a + 4 * h; const f32x4 v = {acc[nb][4 * a], acc[nb][4 * a + 1], acc[nb][4 * a + 2], acc[nb][4 * a + 3]};
                    *(f32x4*)(F.CK + (((size_t)ch * 2 + kv) * 4 + kvh) * 64 + n) = v;
                    if (!S) { if (kv == 0) { v2u wv_; wv_.x = cvtpk(v.x, v.y); wv_.y = cvtpk(v.z, v.w); *(v2u*)((bf16*)(F.ws + WS_CKB) + (((size_t)b * 4 + kvh) * 256 + c) * 64 + n) = wv_; }
                        else { bf16* vt = (bf16*)(F.ws + WS_CVT) + (((size_t)b * 4 + kvh) * 64 + n) * 256 + vpermk(c);
#pragma unroll
                            for (int j = 0; j < 4; ++j) vt[(size_t)j * 256] = (bf16)f2bf(v[j]); } } }
        }
    }
}

template <bool S, int BR, int KV> __device__ __forceinline__ const void* kvrow(const Frame& F, int b, int kvh, int pos) {
    if (!S) return F.KVB + ((size_t)b * TP + pos) * NKV + BR * 512 + KV * 256 + kvh * 64;
    if (BR == 1) {
        if (pos < PAST) { const int pg = F.page_table[b * NPAGES + (pos >> 7)]; return F.cache_slc + ((size_t)pg * 128 + (pos & 127)) * 512 + KV * 256 + kvh * 64; }
        return F.out + OFF_SLC_S + ((size_t)b * TS + (pos - PAST)) * 512 + KV * 256 + kvh * 64;
    }
    const int i = pos - (PAST - 512);
    if (i < 512) return F.state_win + ((size_t)b * 512 + i) * 512 + KV * 256 + kvh * 64;
    return F.out + OFF_WIN_S + ((size_t)b * 512 + 504 + (i - 512)) * 512 + KV * 256 + kvh * 64;
}
template <bool F32> __device__ __forceinline__ void dots3(const void* krow, const LAS float* qs, float& a0, float& a1, float& a2) {
    if (F32) { const f32x4* p = (const f32x4*)krow;
#pragma unroll 4
        for (int i = 0; i < 16; ++i) { const f32x4 k = p[i]; const f32x4 q0 = *(const LAS f32x4*)(qs + 4 * i), q1 = *(const LAS f32x4*)(qs + 64 + 4 * i), q2 = *(const LAS f32x4*)(qs + 128 + 4 * i);
            a0 += q0.x * k.x + q0.y * k.y + q0.z * k.z + q0.w * k.w; a1 += q1.x * k.x + q1.y * k.y + q1.z * k.z + q1.w * k.w; a2 += q2.x * k.x + q2.y * k.y + q2.z * k.z + q2.w * k.w; } }
    else { const v2u* p = (const v2u*)krow;
#pragma unroll 4
        for (int i = 0; i < 16; ++i) { const v2u w = p[i]; const f32x4 k = {bflo(w.x), bfhi(w.x), bflo(w.y), bfhi(w.y)};
            const f32x4 q0 = *(const LAS f32x4*)(qs + 4 * i), q1 = *(const LAS f32x4*)(qs + 64 + 4 * i), q2 = *(const LAS f32x4*)(qs + 128 + 4 * i);
            a0 += q0.x * k.x + q0.y * k.y + q0.z * k.z + q0.w * k.w; a1 += q1.x * k.x + q1.y * k.y + q1.z * k.z + q1.w * k.w; a2 += q2.x * k.x + q2.y * k.y + q2.z * k.z + q2.w * k.w; } }
}
template <bool S, int BR> __device__ __forceinline__ void nsa_tile(const Frame& F, int b, int kvh, int pos0, int lo, int qpos, const float (&sl)[3],
                                                                   const LAS float* qs, LAS float* sc, float (&m)[3], float (&l)[3], float (&o)[3]) {
    const int lane = F.lane, pos = pos0 + lane; const bool valid = pos >= lo && pos <= qpos;
    if (!__any(valid)) return;
    float s[3] = {NEG_INF, NEG_INF, NEG_INF};
    if (valid) { float a0 = 0.f, a1 = 0.f, a2 = 0.f; dots3<S>(kvrow<S, BR, 0>(F, b, kvh, pos), qs, a0, a1, a2); const float dist = (float)(qpos - pos);
        s[0] = a0 - sl[0] * dist; s[1] = a1 - sl[1] * dist; s[2] = a2 - sl[2] * dist; }
#pragma unroll
    for (int g = 0; g < 3; ++g) { const float mn = fmaxf(m[g], wave_max(s[g])); const float alpha = __expf(m[g] - mn); const float p = valid ? __expf(s[g] - mn) : 0.f;
        l[g] = l[g] * alpha + wave_sum(p); o[g] *= alpha; m[g] = mn; sc[g * 64 + lane] = p; }
    LDS_WAIT();
    const int k0 = lo > pos0 ? lo - pos0 : 0, k1 = qpos - pos0 < 63 ? qpos - pos0 : 63;
    for (int k = k0; k <= k1; ++k) { const void* vr = kvrow<S, BR, 1>(F, b, kvh, pos0 + k);
        const float v = S ? ((const float*)vr)[lane] : bf2f(((const bf16*)vr)[lane]);
        o[0] += sc[k] * v; o[1] += sc[64 + k] * v; o[2] += sc[128 + k] * v; }
    LDS_WAIT();
}
template <bool S> __device__ __forceinline__ void nsa_task(const Frame& F, int b, int t, int kvh, LAS float* wl) {
    constexpr int NC = S ? NCS : NCP, NT = S ? 8 : 4, NSB = S ? 129 : 64, NJ = S ? 3 : 1;
    const int lane = F.lane, row = S ? MP + b * TS + t : b * TP + t, qpos = S ? PAST + t : t, cur = qpos >> 6;
    const bf16* prow = F.PROJ + (size_t)row * NINB_PAD;
    LAS float* qs = wl; LAS float* sc = wl + 192; LAS float* scr = wl + 384; LAS float* pc = wl + 576;
    float sl[3], gt[3][3];
#pragma unroll
    for (int g = 0; g < 3; ++g) { const int h = kvh * 3 + g; sl[g] = h < 8 ? exp2f(-(float)(h + 1)) : exp2f(-((float)(h - 8) + 0.5f));
        qs[g * 64 + lane] = bf2f(prow[h * 64 + lane]) * 0.125f;
#pragma unroll
        for (int j = 0; j < 3; ++j) gt[g][j] = sigmoidf_(bf2f(prow[CONV + h * 3 + j])); }
    LDS_WAIT();
    const float* CKb = F.CK + (S ? ((size_t)BP * CHP + (size_t)b * CHS) : (size_t)b * CHP) * 512;
    float sv[3][NT]; float mx[3] = {NEG_INF, NEG_INF, NEG_INF};
#pragma unroll
    for (int j = 0; j < NT; ++j) { const int n = lane + 64 * j; const bool vis = n < NC && 16 * n + 31 <= qpos;
        float a0 = 0.f, a1 = 0.f, a2 = 0.f;
        if (vis) { dots3<true>(CKb + (size_t)n * 512 + kvh * 64, qs, a0, a1, a2); const float dist = (float)(qpos - (16 * n + 31)); a0 -= sl[0] * dist; a1 -= sl[1] * dist; a2 -= sl[2] * dist; }
        sv[0][j] = vis ? a0 : NEG_INF; sv[1][j] = vis ? a1 : NEG_INF; sv[2][j] = vis ? a2 : NEG_INF;
        mx[0] = fmaxf(mx[0], sv[0][j]); mx[1] = fmaxf(mx[1], sv[1][j]); mx[2] = fmaxf(mx[2], sv[2][j]); }
    float oc[3] = {0.f, 0.f, 0.f};
#pragma unroll
    for (int g = 0; g < 3; ++g) { const float mg = wave_max(mx[g]); float sum = 0.f;
#pragma unroll
        for (int j = 0; j < NT; ++j) { sv[g][j] = sv[g][j] > NEG_INF ? __expf(sv[g][j] - mg) : 0.f; sum += sv[g][j]; }
        sum = wave_sum(sum); const float inv = sum > 0.f ? 1.f / sum : 0.f;
#pragma unroll
        for (int j = 0; j < NT; ++j) pc[g * 512 + lane + 64 * j] = sv[g][j] * inv; }
    LDS_WAIT();
    { int nv = qpos >= 31 ? (qpos - 31) / 16 + 1 : 0; if (nv > NC) nv = NC;
      const float* cv = CKb + 256 + kvh * 64 + lane;
      for (int n = 0; n < nv; ++n) { const float v = cv[(size_t)n * 512]; oc[0] += pc[n] * v; oc[1] += pc[512 + n] * v; oc[2] += pc[1024 + n] * v; } }
#pragma unroll
    for (int jj = 0; jj < NJ; ++jj) { const int sb = lane + 64 * jj;
        if (sb < NSB) { float imp = 0.f;
#pragma unroll
            for (int g = 0; g < 3; ++g)
#pragma unroll
                for (int i = 0; i < 4; ++i) { const int idx = 4 * sb + i; if (idx < NT * 64) imp += pc[g * 512 + idx]; }
            const bool forced = sb == 0 || sb == cur || sb == cur - 1;
            scr[sb] = forced ? 1e4f : (sb <= cur ? imp : NEG_INF); } }
    LDS_WAIT();
    unsigned long long selm[NJ];
#pragma unroll
    for (int jj = 0; jj < NJ; ++jj) { const int sb = lane + 64 * jj; bool sel = false;
        if (sb < NSB) { const float mine = scr[sb]; int cnt = 0;
            for (int j = 0; j < NSB; ++j) { const float ot = scr[j]; cnt += (ot > mine || (ot == mine && j < sb)) ? 1 : 0; }
            sel = cnt < 16; }
        selm[jj] = __ballot(sel); }
    float ms[3] = {NEG_INF, NEG_INF, NEG_INF}, ls[3] = {0.f, 0.f, 0.f}, os[3] = {0.f, 0.f, 0.f};
#pragma unroll
    for (int jj = 0; jj < NJ; ++jj) { unsigned long long mk = selm[jj];
        while (mk) { const int sb = 64 * jj + __ffsll((long long)mk) - 1; mk &= mk - 1;
            if (64 * sb > qpos) continue;
            nsa_tile<S, 1>(F, b, kvh, 64 * sb, 0, qpos, sl, qs, sc, ms, ls, os); } }
    float mw[3] = {NEG_INF, NEG_INF, NEG_INF}, lw[3] = {0.f, 0.f, 0.f}, ow[3] = {0.f, 0.f, 0.f};
    { const int lo = qpos - 512 > 0 ? qpos - 512 : 0;
      for (int i0 = 0; i0 < 9; ++i0) nsa_tile<S, 2>(F, b, kvh, qpos - 512 + 64 * i0, lo, qpos, sl, qs, sc, mw, lw, ow); }
#pragma unroll
    for (int g = 0; g < 3; ++g) { const float v = gt[g][0] * oc[g] + gt[g][1] * os[g] / ls[g] + gt[g][2] * ow[g] / lw[g];
        F.Y[(size_t)row * D + (kvh * 3 + g) * 64 + lane] = (bf16)f2bf(v); }
    LDS_WAIT();
}

template <int MODE, int QS> __device__ __forceinline__ void attn_blk(const LAS bf16* Kb, const LAS bf16* VTb, int vtp, const LAS bf16* Ql  , float slope, float fd0, bool lane_ok,
                                                             float& m, float& l, f32x16 (&o)[2], int r, int h) {
    constexpr float STEP = MODE == 1 ? 16.f : 1.f;
    f32x16 acc;
    if (MODE == 0) zero16(acc);
    else { const float nb0 = -slope * fd0, ss = slope * STEP;
#pragma unroll
        for (int i = 0; i < 16; ++i) acc[i] = fmaf(ss, (float)((i & 3) + 8 * (i >> 2)), nb0); }
#pragma unroll
    for (int s = 0; s < 4; ++s) acc = MFMA32(*(const LAS bf16x8*)(Kb + r * KP + 16 * s + 8 * h), *(const LAS bf16x8*)(Ql + QS * s), acc);
    if (MODE != 0) {
        bool interior = lane_ok && fd0 - STEP * 27.f >= 0.f; if (MODE == 3) interior = interior && fd0 <= 512.f;
        if (!__all(interior)) {
#pragma unroll
            for (int i = 0; i < 16; ++i) { const float dist = fd0 - STEP * (float)((i & 3) + 8 * (i >> 2)); bool ok = lane_ok && dist >= 0.f; if (MODE == 3) ok = ok && dist <= 512.f; acc[i] = ok ? acc[i] : NEG_INF; } }
    }
    float bm = fmaxf(fmaxf(acc[0], acc[1]), fmaxf(acc[2], acc[3]));
#pragma unroll
    for (int i = 4; i < 16; i += 4) bm = fmaxf(bm, fmaxf(fmaxf(acc[i], acc[i + 1]), fmaxf(acc[i + 2], acc[i + 3])));
    bm = fmaxf(bm, __shfl_xor(bm, 32));
    const float mn = fmaxf(m, bm);
    if (__any(mn > m)) { const float ms = mn == NEG_INF ? 0.f : mn, alpha = __builtin_amdgcn_exp2f((m - ms) * LOG2E); l *= alpha; m = mn;
#pragma unroll
        for (int i = 0; i < 16; ++i) { o[0][i] *= alpha; o[1][i] *= alpha; } }
    const float nms = m == NEG_INF ? 0.f : -m * LOG2E;
    float ls = 0.f; float p[16];
#pragma unroll
    for (int i = 0; i < 16; ++i) { p[i] = __builtin_amdgcn_exp2f(fmaf(acc[i], LOG2E, nms)); ls += p[i]; }
    l += ls;
    v4u pw[2];
#pragma unroll
    for (int s = 0; s < 2; ++s) { pw[s].x = cvtpk(p[8 * s], p[8 * s + 1]); pw[s].y = cvtpk(p[8 * s + 2], p[8 * s + 3]); pw[s].z = cvtpk(p[8 * s + 4], p[8 * s + 5]); pw[s].w = cvtpk(p[8 * s + 6], p[8 * s + 7]); }
#pragma unroll
    for (int db = 0; db < 2; ++db)
#pragma unroll
        for (int s = 0; s < 2; ++s) o[db] = MFMA32(*(const LAS bf16x8*)(VTb + (db * 32 + r) * vtp + 16 * s + 8 * h), __builtin_bit_cast(bf16x8, pw[s]), o[db]);
    __builtin_amdgcn_sched_barrier(0);
}
template <int MODE, int QS, bool PS = false> __device__ __forceinline__ void attn_tile64(const LAS bf16* Kt, const LAS bf16* VTt, int vtp, const LAS bf16* Ql, float slope, float fd0, bool lane_ok,
                                                                float& m, float& l, f32x16 (&o)[2], int r, int h, const bool upd = true  ,
                                                                f32x4* ps = nullptr  ) {
    constexpr float STEP = MODE == 1 ? 16.f : 1.f;
    f32x16 acc[2];
    if (MODE == 0) { zero16(acc[0]); zero16(acc[1]); }
    else { const float nb0 = -slope * fd0, ss = slope * STEP, d1 = ss * 32.f;
#pragma unroll
        for (int i = 0; i < 16; ++i) { acc[0][i] = fmaf(ss, (float)((i & 3) + 8 * (i >> 2)), nb0); acc[1][i] = acc[0][i] + d1; } }
#pragma unroll
    for (int s = 0; s < 4; ++s) { const bf16x8 q = *(const LAS bf16x8*)(Ql + QS * s);
        acc[0] = MFMA32(*(const LAS bf16x8*)(Kt + r * KP + 16 * s + 8 * h), q, acc[0]);
        acc[1] = MFMA32(*(const LAS bf16x8*)(Kt + (32 + r) * KP + 16 * s + 8 * h), q, acc[1]); }
    if (MODE != 0) {
        bool interior = lane_ok && fd0 - STEP * 59.f >= 0.f; if (MODE == 3) interior = interior && fd0 <= 512.f;
        if (!__all(interior)) {
#pragma unroll
            for (int kb = 0; kb < 2; ++kb)
#pragma unroll
                for (int i = 0; i < 16; ++i) { const float dist = fd0 - STEP * (float)(32 * kb + (i & 3) + 8 * (i >> 2)); bool ok = lane_ok && dist >= 0.f; if (MODE == 3) ok = ok && dist <= 512.f; acc[kb][i] = ok ? acc[kb][i] : NEG_INF; } }
    }
    if (upd) {
    float bm = NEG_INF;
#pragma unroll
    for (int i = 0; i < 16; i += 2) bm = fmaxf(bm, fmaxf(fmaxf(acc[0][i], acc[0][i + 1]), fmaxf(acc[1][i], acc[1][i + 1])));
    bm = fmaxf(bm, __shfl_xor(bm, 32));
    const float mn = fmaxf(m, bm);
    if (__any(mn > m)) { const float ms = mn == NEG_INF ? 0.f : mn, alpha = __builtin_amdgcn_exp2f((m - ms) * LOG2E); l *= alpha; m = mn;
#pragma unroll
        for (int i = 0; i < 16; ++i) { o[0][i] *= alpha; o[1][i] *= alpha; } }
    }
    const float nms = m == NEG_INF ? 0.f : -m * LOG2E;
    float ls = 0.f; v4u pw[2][2];
#pragma unroll
    for (int kb = 0; kb < 2; ++kb) { float p[16];
#pragma unroll
        for (int i = 0; i < 16; ++i) { p[i] = __builtin_amdgcn_exp2f(fmaf(acc[kb][i], LOG2E, nms)); if (!PS) ls += p[i]; }
        if (PS) {
#pragma unroll
            for (int a = 0; a < 4; ++a) { const float s4 = (p[4 * a] + p[4 * a + 1]) + (p[4 * a + 2] + p[4 * a + 3]); ps[kb][a] = s4; ls += s4; } }
#pragma unroll
        for (int s = 0; s < 2; ++s) { pw[kb][s].x = cvtpk(p[8 * s], p[8 * s + 1]); pw[kb][s].y = cvtpk(p[8 * s + 2], p[8 * s + 3]); pw[kb][s].z = cvtpk(p[8 * s + 4], p[8 * s + 5]); pw[kb][s].w = cvtpk(p[8 * s + 6], p[8 * s + 7]); } }
    l += ls;
#pragma unroll
    for (int kb = 0; kb < 2; ++kb)
#pragma unroll
        for (int s = 0; s < 2; ++s)
#pragma unroll
            for (int db = 0; db < 2; ++db) o[db] = MFMA32(*(const LAS bf16x8*)(VTt + (db * 32 + r) * vtp + 32 * kb + 16 * s + 8 * h), __builtin_bit_cast(bf16x8, pw[kb][s]), o[db]);
    __builtin_amdgcn_sched_barrier(0);
}
__device__ __forceinline__ v4u qscale8(const v4u& q) { v4u r_; r_.x = cvtpk(bflo(q.x) * 0.125f, bfhi(q.x) * 0.125f); r_.y = cvtpk(bflo(q.y) * 0.125f, bfhi(q.y) * 0.125f); r_.z = cvtpk(bflo(q.z) * 0.125f, bfhi(q.z) * 0.125f); r_.w = cvtpk(bflo(q.w) * 0.125f, bfhi(q.w) * 0.125f); return r_; }
__device__ __forceinline__ void memattn_mfma_phase(Frame& F, int l, int ldp, int qoff, unsigned* ctr  ) {
    LAS bf16* Ks = (LAS bf16*)F.lds; LAS bf16* VTs = Ks + 256 * KP; constexpr int VTP = 264;
    const int lane = F.lane, r = lane & 31, h = lane >> 5, tid = F.tid;
    constexpr int NU = BP * 4 * 16 + BS * 4;
    volatile LAS int* qid = (volatile LAS int*)(F.lds + 123968);
    for (int u = F.vcu;; u += F.G) {
        if (ctr) { __syncthreads(); if (F.wave == 0 && lane_id() == 0) *qid = (int)atomicAdd(ctr, 1u); __syncthreads(); u = *qid; }
        if (u >= NU) break;
        int row0, nrows, hd; const bool S = u >= BP * 4 * 16;
        if (!S) { const int b = u >> 6, ch = u & 15; hd = (u >> 4) & 3; row0 = b * TP + ch * 256; nrows = 256; } else { const int v = u - BP * 4 * 16; hd = v & 3; row0 = MP + (v >> 2) * TS; nrows = TS; }
        v4u qv_[4];
        { const int rq = F.wave * 32 + r, row = row0 + (rq < nrows ? rq : 0);
#pragma unroll
          for (int s = 0; s < 4; ++s) qv_[s] = *(const v4u*)(F.PROJ + (size_t)row * ldp + qoff + hd * 64 + 16 * s + 8 * h); }
        __syncthreads();
        if (!S) { const int b = u >> 6, ch = u & 15; hd = (u >> 4) & 3; row0 = b * TP + ch * 256; nrows = 256;
            const bf16* kg = (const bf16*)(F.ws + WS_MKB) + ((size_t)l * 1024 + b * 256) * 256 + hd * 64;
            const bf16* vg = (const bf16*)(F.ws + WS_MVT) + ((((size_t)l * 4 + b) * 4 + hd) * 64) * 256;
            v4u kb_[4], vb_[4];
#pragma unroll
            for (int it = 0; it < 4; ++it) { const int i = tid + 512 * it; kb_[it] = *(const v4u*)(kg + (size_t)(i >> 3) * 256 + (i & 7) * 8); vb_[it] = *(const v4u*)(vg + (size_t)(i >> 5) * 256 + (i & 31) * 8); }
#pragma unroll
            for (int it = 0; it < 4; ++it) { const int i = tid + 512 * it; *(LAS v4u*)(Ks + (i >> 3) * KP + (i & 7) * 8) = kb_[it]; *(LAS v4u*)(VTs + (i >> 5) * VTP + (i & 31) * 8) = vb_[it]; } }
        else { const int v = u - BP * 4 * 16, b = v >> 2; hd = v & 3; row0 = MP + b * TS; nrows = TS;
            const float* kv = F.cache_mem + ((size_t)l * BS + b) * NMEM * 512 + hd * 64;
            f32x4 kk_[4][2], vv_[4][2];
#pragma unroll
            for (int it = 0; it < 4; ++it) { const int i = tid + 512 * it; const float* kp = kv + (size_t)(i >> 3) * 512 + (i & 7) * 8;
                kk_[it][0] = *(const f32x4*)kp; kk_[it][1] = *(const f32x4*)(kp + 4); vv_[it][0] = *(const f32x4*)(kp + 256); vv_[it][1] = *(const f32x4*)(kp + 260); }
#pragma unroll
            for (int it = 0; it < 4; ++it) { const int i = tid + 512 * it, rr = i >> 3, c = i & 7;
                *(LAS v4u*)(Ks + rr * KP + c * 8) = pack8(kk_[it][0], kk_[it][1]); LAS bf16* vt = VTs + (c * 8) * VTP + vpermk(rr);
#pragma unroll
                for (int j = 0; j < 4; ++j) { vt[j * VTP] = (bf16)f2bf(vv_[it][0][j]); vt[(j + 4) * VTP] = (bf16)f2bf(vv_[it][1][j]); } } }
        __syncthreads();
        if (F.wave * 32 < nrows) {
            const int rq = F.wave * 32 + r, row = row0 + (rq < nrows ? rq : 0);
            LAS bf16* Ql = VTs + 64 * VTP + (F.wave * 32 + r) * KP + 8 * h;
#pragma unroll
            for (int s = 0; s < 4; ++s) *(LAS v4u*)(Ql + 16 * s) = qscale8(qv_[s]);
            float m = NEG_INF, ll = 0.f; f32x16 o[2]; zero16(o[0]); zero16(o[1]);
            for (int kt = 0; kt < 4; ++kt) attn_tile64<0, 16>(Ks + kt * 64 * KP, VTs + kt * 64, VTP, Ql, 0.f, 0.f, true, m, ll, o, r, h);
            ll += __shfl_xor(ll, 32); const float inv = 1.f / ll;
            if (rq < nrows) {
#pragma unroll
                for (int db = 0; db < 2; ++db)
#pragma unroll
                    for (int a = 0; a < 4; ++a) { v2u w; w.x = cvtpk(o[db][4 * a] * inv, o[db][4 * a + 1] * inv); w.y = cvtpk(o[db][4 * a + 2] * inv, o[db][4 * a + 3] * inv);
                        *(v2u*)(F.Y + (size_t)row * D + CONV + hd * 64 + db * 32 + 8 * a + 4 * h) = w; } }
        }
    }
    __syncthreads();
}

struct TileSrc { const bf16* k; size_t ks; const bf16* vt; size_t vs; };
template <int BR> __device__ __forceinline__ TileSrc tile_src(const Frame& F, int b, int kvh, int id) {
    TileSrc t;
    if (BR == 0) { t.k = (const bf16*)(F.ws + WS_CKB) + (((size_t)b * 4 + kvh) * 256 + 64 * id) * 64; t.ks = 64; t.vt = (const bf16*)(F.ws + WS_CVT) + (((size_t)b * 4 + kvh) * 64) * 256 + 64 * id; t.vs = 256; }
    else { const size_t hb = (((size_t)(BR - 1) * 4 + b) * 4 + kvh); t.k = (const bf16*)(F.ws + WS_KTB) + ((hb << 12) + 64 * id) * 64; t.ks = 64; t.vt = (const bf16*)(F.ws + WS_VTB) + ((hb * 64 + id) << 12); t.vs = 64; }
    return t;
}
__device__ __forceinline__ void tile_issue(const TileSrc& t, int tid_, v4u& kr, v4u& vr) { const unsigned tid = ((unsigned)tid_ & ~63u) | (unsigned)lane_id();
    const unsigned rr = tid >> 3, c = tid & 7u;
    kr = *(const v4u*)((const char*)t.k + (rr * (unsigned)t.ks + c * 8u) * 2u); vr = *(const v4u*)((const char*)t.vt + (rr * (unsigned)t.vs + c * 8u) * 2u); }
__device__ __forceinline__ void tile_commit(LAS bf16* Kt, LAS bf16* VTt, int tid, const v4u& kr, const v4u& vr) { const int rr = tid >> 3, c = tid & 7; *(LAS v4u*)(Kt + rr * KP + c * 8) = kr; *(LAS v4u*)(VTt + rr * KP + c * 8) = vr; }

template <int BR> __device__ __forceinline__ void nsa_branch(const Frame& F, int b, int kvh, unsigned long long mask, LAS bf16* Kt, LAS bf16* VTt, const LAS bf16* Ql, const float (&sl)[3],
                                                             int t, int tw0, unsigned selE, unsigned selO, unsigned wvE, unsigned wvO, float (&m)[3], float (&l)[3], f32x16 (&o)[3][2],
                                                             v4u kr, v4u vr, const int pre_id  ) {
    const int tid = F.tid, r = F.lane & 31, h = F.lane >> 5;
    bool first = true;
    constexpr int BUF2 = (118784 - 0) / 2;
    int cur = 0;
    if (mask) { const int top = 63 - __clzll((long long)mask); if (top != pre_id) { const TileSrc ts = tile_src<BR>(F, b, kvh, top); tile_issue(ts, tid, kr, vr); }
        __syncthreads();
        tile_commit(Kt, VTt, tid, kr, vr);
        const unsigned long long m2 = mask & ~(1ull << (63 - __clzll((long long)mask)));
        if (m2) { const TileSrc t2 = tile_src<BR>(F, b, kvh, 63 - __clzll((long long)m2)); tile_issue(t2, tid, kr, vr); } }
    while (mask) {
        const int id = 63 - __clzll((long long)mask); mask &= ~(1ull << id);
        __syncthreads();
        if (mask) { tile_commit(Kt + (cur ^ 1) * BUF2, VTt + (cur ^ 1) * BUF2, tid, kr, vr);
            const unsigned long long m2 = mask & ~(1ull << (63 - __clzll((long long)mask)));
            if (m2) { const TileSrc t2 = tile_src<BR>(F, b, kvh, 63 - __clzll((long long)m2)); tile_issue(t2, tid, kr, vr); } }
#if STAG_SLEEP
        if (F.wave >= 4) __builtin_amdgcn_s_sleep(STAG_SLEEP);
#endif
        const LAS bf16* Kc = Kt + cur * BUF2; const LAS bf16* Vc = VTt + cur * BUF2; cur ^= 1;
        bool wave_in, lane_ok = true;
        if (BR == 1) { const unsigned wb = (id & 1) ? wvO : wvE; wave_in = (wb >> (id >> 1)) & 1u; const unsigned lb = (id & 1) ? selO : selE; lane_ok = (lb >> (id >> 1)) & 1u; }
        else wave_in = (64 * id + 63 >= tw0 - 512) && (64 * id <= tw0 + 31);
        if (wave_in) { const float fd0 = (float)(t - (64 * id + 4 * h));
            const bool any = BR == 1 ? (lane_ok && fd0 >= 0.f) : (fd0 >= 0.f && fd0 - 59.f <= 512.f);
            if (__any(any)) {
#pragma unroll
                for (int g = 0; g < 3; ++g) attn_tile64<BR == 1 ? 2 : 3, 512>(Kc, Vc, KP, Ql + g * 2048, sl[g], fd0, lane_ok, m[g], l[g], o[g], r, h, first);
                first = false; }
        }
    }
}
__device__ __forceinline__ void cmp_scores(f32x16& acc, const LAS bf16* Kb, const LAS bf16* Qg, float slope, float fd0, int r, int h) {
    const float nb0 = -slope * fd0, ss = slope * 16.f;
#pragma unroll
    for (int i = 0; i < 16; ++i) acc[i] = fmaf(ss, (float)((i & 3) + 8 * (i >> 2)), nb0);
#pragma unroll
    for (int s = 0; s < 4; ++s) acc = MFMA32(*(const LAS bf16x8*)(Kb + r * KP + 16 * s + 8 * h), *(const LAS bf16x8*)(Qg + 512 * s), acc);
    if (!__all(fd0 - 432.f >= 0.f)) {
#pragma unroll
        for (int i = 0; i < 16; ++i) acc[i] = fd0 - 16.f * (float)((i & 3) + 8 * (i >> 2)) >= 0.f ? acc[i] : NEG_INF; }
}
__device__ __forceinline__ void nsa_prompt_unit(Frame& F, int unit) {
    const int lane = lane_id();
    const int tid = F.wave * 64 + lane, r = lane & 31, h = lane >> 5, w = F.wave;
    const int b = unit >> 6, kvh = (unit >> 4) & 3, u = unit & 15, t0 = u * 256, tw0 = t0 + 32 * w, t = tw0 + r, row = b * TP + t, cur = tw0 >> 6;
    LAS bf16* Kt = (LAS bf16*)F.lds; LAS bf16* VTt = Kt + 64 * KP; volatile LAS unsigned* uni = (volatile LAS unsigned*)(F.lds + 2 * 64 * KP * 2);
    const bf16* prow = F.PROJ + (size_t)row * NINB_PAD;
    float sl[3];
    const int ntile = (t0 + 255 - 31) / 16 / 64 + 1;
    v4u pkr0, pvr0; { const TileSrc ts = tile_src<0>(F, b, kvh, ntile - 1); tile_issue(ts, tid, pkr0, pvr0); }
    LAS bf16* Ql = (LAS bf16*)(F.lds + 20480) + (w * 12 * 64 + lane) * 8;
#pragma unroll
    for (int g = 0; g < 3; ++g) { const int hh = kvh * 3 + g; sl[g] = hh < 8 ? exp2f(-(float)(hh + 1)) : exp2f(-((float)(hh - 8) + 0.5f));
#pragma unroll
        for (int s = 0; s < 4; ++s) *(LAS v4u*)(Ql + (g * 4 + s) * 512) = qscale8(*(const v4u*)(prow + hh * 64 + 16 * s + 8 * h)); }
    if (tid < 2) uni[tid] = 0u;
    float mc[3] = {NEG_INF, NEG_INF, NEG_INF}, lc[3] = {0.f, 0.f, 0.f};
    f32x16 o[3][2];
#pragma unroll
    for (int g = 0; g < 3; ++g) { zero16(o[g][0]); zero16(o[g][1]); }
    { v4u pkr = pkr0, pvr = pvr0;
      for (int j = ntile - 1; j >= 0; --j) {
        __syncthreads(); tile_commit(Kt, VTt, tid, pkr, pvr); __syncthreads();
        if (j > 0) { const TileSrc ts = tile_src<0>(F, b, kvh, j - 1); tile_issue(ts, tid, pkr, pvr); }
        if (1024 * j <= tw0) { const float fd0 = (float)(t - 31 - 1024 * j - 64 * h);
#pragma unroll
            for (int g = 0; g < 3; ++g) { f32x4 ps[2];
                attn_tile64<1, 512, true>(Kt, VTt, KP, Ql + g * 2048, sl[g], fd0, true, mc[g], lc[g], o[g], r, h, true, ps);
                const int ln = lane_id(); const size_t sb_ = (size_t)(unit * 8 + w) * 24 + (j * 3 + g) * 2;
                f32x4* sp = (f32x4*)(F.ws + WS_IMPS) + sb_ * 64 + ln; sp[0] = ps[0]; sp[64] = ps[1];
                ((float*)(F.ws + WS_IMPM))[((size_t)(unit * 8 + w) * 12 + j * 3 + g) * 64 + ln] = mc[g]; } }
      } }
    float il[3];
#pragma unroll
    for (int g = 0; g < 3; ++g) { const float lt = lc[g] + __shfl_xor(lc[g], 32); il[g] = lt > 0.f ? __builtin_amdgcn_rcpf(lt) : 0.f; }
    bf16 gate_[3];
#pragma unroll
    for (int g = 0; g < 3; ++g) { const int ln = lane_id(); gate_[g] = F.PROJ[(size_t)(b * TP + tw0 + (ln & 31)) * NINB_PAD + CONV + (kvh * 3 + g) * 3 + 0]; }
    __builtin_amdgcn_sched_barrier(0);
#pragma unroll
    for (int g = 0; g < 3; ++g) { const int ln = lane_id(); const float gc = il[g] * sigmoidf_(bf2f(gate_[g]));
        v2u* oa = (v2u*)(F.ws + WS_OACC) + ((size_t)(unit * 8 + w) * 24) * 64 + ln;
#pragma unroll
        for (int db = 0; db < 2; ++db)
#pragma unroll
            for (int a = 0; a < 4; ++a) { v2u pk_; pk_.x = cvtpk(o[g][db][4 * a] * gc, o[g][db][4 * a + 1] * gc); pk_.y = cvtpk(o[g][db][4 * a + 2] * gc, o[g][db][4 * a + 3] * gc); oa[((g * 2 + db) * 4 + a) * 64] = pk_; } }
    __builtin_amdgcn_sched_barrier(0);
    float imp[32];
#pragma unroll
    for (int i = 0; i < 32; ++i) imp[i] = 0.f;
    { float mr[4][3];
#pragma unroll
      for (int j = 0; j < 4; ++j) if (j < ntile && 1024 * j <= tw0) { const int ln = lane_id();
#pragma unroll
          for (int g = 0; g < 3; ++g) mr[j][g] = ((const float*)(F.ws + WS_IMPM))[((size_t)(unit * 8 + w) * 12 + j * 3 + g) * 64 + ln]; }
      __builtin_amdgcn_sched_barrier(0);
#pragma unroll
      for (int j = 0; j < 4; ++j) if (j < ntile && 1024 * j <= tw0) {
        const int ln = lane_id(); f32x4 pv[3][2];
#pragma unroll
        for (int g = 0; g < 3; ++g) { const f32x4* sp = (const f32x4*)(F.ws + WS_IMPS) + ((size_t)(unit * 8 + w) * 24 + (j * 3 + g) * 2) * 64 + ln; pv[g][0] = sp[0]; pv[g][1] = sp[64]; }
        __builtin_amdgcn_sched_barrier(0);
#pragma unroll
        for (int g = 0; g < 3; ++g) { const float sc_ = il[g] > 0.f ? il[g] * __builtin_amdgcn_exp2f((mr[j][g] - mc[g]) * LOG2E) : 0.f;
#pragma unroll
            for (int kb = 0; kb < 2; ++kb)
#pragma unroll
                for (int a = 0; a < 4; ++a) imp[8 * j + 4 * kb + a] = fmaf(pv[g][kb][a], sc_, imp[8 * j + 4 * kb + a]); } } }
    const int cmax_ = (t0 + 255) >> 6;
    v4u pkr, pvr; { const TileSrc ts = tile_src<1>(F, b, kvh, cmax_); tile_issue(ts, tid, pkr, pvr); }
    unsigned selE, selO, wvE, wvO;
    for (int rep_ = 0; rep_ < REP_TOPK; ++rep_)
    {
      unsigned key[32];
#pragma unroll
      for (int i = 0; i < 32; ++i) { const int sb = 2 * i + h; const bool forced = sb == 0 || sb == cur || sb == cur - 1; key[i] = forced ? 0xFFFFFFFFu : (sb <= cur ? __float_as_uint(imp[i]) + 1u : 0u); }
      unsigned T = 0u; int cntT = 64;
#pragma unroll 1
      for (int bit = 30; bit >= 0; --bit) { const unsigned cand = T | (1u << bit); int c = 0;
#pragma unroll
          for (int i = 0; i < 32; ++i) c += key[i] >= cand ? 1 : 0;
          c += __shfl_xor(c, 32);
          T = c >= 16 ? cand : T; cntT = c >= 16 ? c : cntT;
          if (__all(cntT == 16)) break; }
      unsigned gt = 0u, eq = 0u;
#pragma unroll
      for (int i = 0; i < 32; ++i) { gt |= (key[i] > T ? 1u : 0u) << i; eq |= (key[i] == T ? 1u : 0u) << i; }
      int ngt = __popc(gt); ngt += __shfl_xor(ngt, 32);
      const int need = 16 - ngt; const unsigned eqo = (unsigned)__shfl_xor((int)eq, 32);
      unsigned bits = gt;
#pragma unroll
      for (int i = 0; i < 32; ++i) { const unsigned lo_m = (1u << i) - 1u, lo_o = h ? (2u << i) - 1u : lo_m;
          const int below = __popc(eq & lo_m) + __popc(eqo & lo_o);
          bits |= (((eq >> i) & 1u) && below < need ? 1u : 0u) << i; }
      const unsigned other = (unsigned)__shfl_xor((int)bits, 32);
      selE = h ? other : bits; selO = h ? bits : other; }
    wvE = selE; wvO = selO;
#pragma unroll
    for (int off = 1; off < 32; off <<= 1) { wvE |= (unsigned)__shfl_xor((int)wvE, off); wvO |= (unsigned)__shfl_xor((int)wvO, off); }
    wvE = (unsigned)__builtin_amdgcn_readfirstlane((int)wvE); wvO = (unsigned)__builtin_amdgcn_readfirstlane((int)wvO);
    __syncthreads();
    if (lane == 0) { atomicOr((unsigned*)&uni[0], wvE); atomicOr((unsigned*)&uni[1], wvO); }
    __syncthreads();
    unsigned long long smask;
    { unsigned long long e = uni[0], od = uni[1];
      e = (e | (e << 16)) & 0x0000FFFF0000FFFFull; e = (e | (e << 8)) & 0x00FF00FF00FF00FFull; e = (e | (e << 4)) & 0x0F0F0F0F0F0F0F0Full; e = (e | (e << 2)) & 0x3333333333333333ull; e = (e | (e << 1)) & 0x5555555555555555ull;
      od = (od | (od << 16)) & 0x0000FFFF0000FFFFull; od = (od | (od << 8)) & 0x00FF00FF00FF00FFull; od = (od | (od << 4)) & 0x0F0F0F0F0F0F0F0Full; od = (od | (od << 2)) & 0x3333333333333333ull; od = (od | (od << 1)) & 0x5555555555555555ull;
      smask = e | (od << 1);
      const int cmax = (t0 + 255) >> 6; if (cmax < 63) smask &= (2ull << cmax) - 1ull; }
    float mm[3] = {NEG_INF, NEG_INF, NEG_INF}, ll[3] = {0.f, 0.f, 0.f};
#pragma unroll
    for (int g = 0; g < 3; ++g) { zero16(o[g][0]); zero16(o[g][1]); }
    nsa_branch<1>(F, b, kvh, smask, Kt, VTt, Ql, sl, t, tw0, selE, selO, wvE, wvO, mm, ll, o, pkr, pvr, cmax_);
    { const TileSrc ts = tile_src<2>(F, b, kvh, cmax_); tile_issue(ts, tid, pkr, pvr); }
    { bf16 gs_[3]; v2u qc_[2][4];
#pragma unroll
      for (int g = 0; g < 3; ++g) { const int ln = lane_id(); gs_[g] = F.PROJ[(size_t)(b * TP + tw0 + (ln & 31)) * NINB_PAD + CONV + (kvh * 3 + g) * 3 + 1]; }
      { const int ln = lane_id(); const v2u* oa = (const v2u*)(F.ws + WS_OACC) + ((size_t)(unit * 8 + w) * 24) * 64 + ln;
#pragma unroll
        for (int db = 0; db < 2; ++db)
#pragma unroll
            for (int a = 0; a < 4; ++a) qc_[db][a] = oa[(db * 4 + a) * 64]; }
#pragma unroll
      for (int g = 0; g < 3; ++g) { const int ln = lane_id(); const float lt = ll[g] + __shfl_xor(ll[g], 32);
        v2u* oa = (v2u*)(F.ws + WS_OACC) + ((size_t)(unit * 8 + w) * 24) * 64 + ln;
        v2u qn_[2][4];
        if (g < 2) {
#pragma unroll
            for (int db = 0; db < 2; ++db)
#pragma unroll
                for (int a = 0; a < 4; ++a) qn_[db][a] = oa[(((g + 1) * 2 + db) * 4 + a) * 64]; }
        __builtin_amdgcn_sched_barrier(0);
        const float sc_ = sigmoidf_(bf2f(gs_[g])) / lt;
#pragma unroll
        for (int db = 0; db < 2; ++db)
#pragma unroll
            for (int a = 0; a < 4; ++a) { const v2u q_ = qc_[db][a]; v2u pk_;
                pk_.x = cvtpk(bflo(q_.x) + o[g][db][4 * a] * sc_, bfhi(q_.x) + o[g][db][4 * a + 1] * sc_); pk_.y = cvtpk(bflo(q_.y) + o[g][db][4 * a + 2] * sc_, bfhi(q_.y) + o[g][db][4 * a + 3] * sc_); oa[((g * 2 + db) * 4 + a) * 64] = pk_; }
        if (g < 2) {
#pragma unroll
            for (int db = 0; db < 2; ++db)
#pragma unroll
                for (int a = 0; a < 4; ++a) qc_[db][a] = qn_[db][a]; }
        __builtin_amdgcn_sched_barrier(0); } }
    for (int rep_ = 0; rep_ < REP_WIN; ++rep_) {
#pragma unroll
    for (int g = 0; g < 3; ++g) { mm[g] = NEG_INF; ll[g] = 0.f; zero16(o[g][0]); zero16(o[g][1]); }
    { const int lo_ = (t0 - 512 > 0 ? t0 - 512 : 0) >> 6, hi_ = (t0 + 255) >> 6;
      const unsigned long long wmask = (hi_ >= 63 ? ~0ull : ((2ull << hi_) - 1ull)) & ~((1ull << lo_) - 1ull);
      nsa_branch<2>(F, b, kvh, wmask, Kt, VTt, Ql, sl, t, tw0, 0u, 0u, 0u, 0u, mm, ll, o, pkr, pvr, REP_WIN == 1 ? cmax_ : -1); } }
    { bf16 gs_[3]; v2u qc_[2][4];
#pragma unroll
      for (int g = 0; g < 3; ++g) { const int ln = lane_id(); gs_[g] = F.PROJ[(size_t)(b * TP + tw0 + (ln & 31)) * NINB_PAD + CONV + (kvh * 3 + g) * 3 + 2]; }
      { const int ln = lane_id(); const v2u* oa = (const v2u*)(F.ws + WS_OACC) + ((size_t)(unit * 8 + w) * 24) * 64 + ln;
#pragma unroll
        for (int db = 0; db < 2; ++db)
#pragma unroll
            for (int a = 0; a < 4; ++a) qc_[db][a] = oa[(db * 4 + a) * 64]; }
#pragma unroll
      for (int g = 0; g < 3; ++g) { const int ln = lane_id(), row2 = b * TP + tw0 + (ln & 31), h2 = ln >> 5; const float lt = ll[g] + __shfl_xor(ll[g], 32);
        const v2u* oa = (const v2u*)(F.ws + WS_OACC) + ((size_t)(unit * 8 + w) * 24) * 64 + ln;
        v2u qn_[2][4];
        if (g < 2) {
#pragma unroll
            for (int db = 0; db < 2; ++db)
#pragma unroll
                for (int a = 0; a < 4; ++a) qn_[db][a] = oa[(((g + 1) * 2 + db) * 4 + a) * 64]; }
        __builtin_amdgcn_sched_barrier(0);
        const float sc_ = sigmoidf_(bf2f(gs_[g])) / lt;
#pragma unroll
        for (int db = 0; db < 2; ++db)
#pragma unroll
            for (int a = 0; a < 4; ++a) { const v2u q_ = qc_[db][a]; const f32x4 v = (f32x4){bflo(q_.x), bfhi(q_.x), bflo(q_.y), bfhi(q_.y)} + (f32x4){o[g][db][4 * a], o[g][db][4 * a + 1], o[g][db][4 * a + 2], o[g][db][4 * a + 3]} * sc_;
                v2u wv_; wv_.x = cvtpk(v.x, v.y); wv_.y = cvtpk(v.z, v.w);
                *(v2u*)(F.Y + (size_t)row2 * D + (kvh * 3 + g) * 64 + db * 32 + 8 * a + 4 * h2) = wv_; }
        if (g < 2) {
#pragma unroll
            for (int db = 0; db < 2; ++db)
#pragma unroll
                for (int a = 0; a < 4; ++a) qc_[db][a] = qn_[db][a]; }
        __builtin_amdgcn_sched_barrier(0); } }
    __syncthreads();
}

constexpr int SU_K = 0, SU_VT = 36864, SU_OW = 70656, SU_OUT = 103424, SU_MW = 111616, SU_ML = 113664, SU_IMP = 113920, SU_SEL = 118144, SU_LIST = 119296, SU_Q = 119872, SU_QID = 123968, SU_VTP = 264;
static_assert(SU_QID + 64 <= MISC_OFF, "sample-unit LDS map");
template <int BR> __device__ __forceinline__ const float* su_row(const Frame& F, int b, int kvh, int chunk, int slot, const volatile LAS int* list, int count) {
    if (BR == 0) { const int n = chunk * 256 + slot; if (n >= NCS) return nullptr; return F.CK + ((size_t)BP * CHP + (size_t)b * CHS + n) * 512 + kvh * 64; }
    if (BR == 1) { const int e = chunk * 4 + (slot >> 6); if (e >= count) return nullptr; const int pos = 64 * list[e] + (slot & 63);
        if (pos < PAST) { const int pg = F.page_table[b * NPAGES + (pos >> 7)]; return F.cache_slc + ((size_t)pg * 128 + (pos & 127)) * 512 + kvh * 64; }
        if (pos < PAST + TS) return F.out + OFF_SLC_S + ((size_t)b * TS + (pos - PAST)) * 512 + kvh * 64;
        return nullptr; }
    const int i = chunk * 256 + slot;
    if (i < 512) return F.state_win + ((size_t)b * 512 + i) * 512 + kvh * 64;
    if (i < 520) return F.out + OFF_WIN_S + ((size_t)b * 512 + 504 + (i - 512)) * 512 + kvh * 64;
    return nullptr;
}
template <int BR> __device__ __forceinline__ void su_stage(const Frame& F, int b, int kvh, int chunk, int tid, const volatile LAS int* list, int count) {
    LAS bf16* Ks = (LAS bf16*)(F.lds + SU_K); LAS bf16* VTs = (LAS bf16*)(F.lds + SU_VT);
    const float* rp[4];
#pragma unroll
    for (int it = 0; it < 4; ++it) rp[it] = su_row<BR>(F, b, kvh, chunk, (tid + 512 * it) >> 3, list, count);
    f32x4 kk[4][2], vv[4][2];
#pragma unroll
    for (int it = 0; it < 4; ++it) { const int c = tid & 7;
        if (rp[it]) { kk[it][0] = *(const f32x4*)(rp[it] + c * 8); kk[it][1] = *(const f32x4*)(rp[it] + c * 8 + 4); vv[it][0] = *(const f32x4*)(rp[it] + 256 + c * 8); vv[it][1] = *(const f32x4*)(rp[it] + 256 + c * 8 + 4); }
        else { kk[it][0] = kk[it][1] = vv[it][0] = vv[it][1] = (f32x4){0.f, 0.f, 0.f, 0.f}; } }
#pragma unroll
    for (int it = 0; it < 4; ++it) { const int slot = (tid + 512 * it) >> 3, c = tid & 7;
        *(LAS v4u*)(Ks + slot * KP + c * 8) = pack8(kk[it][0], kk[it][1]);
        LAS bf16* vt = VTs + (c * 8) * SU_VTP + vpermk(slot);
#pragma unroll
        for (int j = 0; j < 4; ++j) { vt[j * SU_VTP] = (bf16)f2bf(vv[it][0][j]); vt[(j + 4) * SU_VTP] = (bf16)f2bf(vv[it][1][j]); } }
}
template <bool STORE_ML> __device__ __forceinline__ void su_merge(const Frame& F, int w, int lane, float m, float l, const f32x16 (&o)[2], float gate) {
    LAS float* oW = (LAS float*)(F.lds + SU_OW); LAS float* outL = (LAS float*)(F.lds + SU_OUT); LAS float* mW = (LAS float*)(F.lds + SU_MW); LAS float* lW = mW + 256; LAS float* ML = (LAS float*)(F.lds + SU_ML);
    const int col = lane & 31;
    l += __shfl_xor(l, 32);
    if (lane < 32) { mW[w * 32 + col] = m; lW[w * 32 + col] = l; }
#pragma unroll
    for (int db = 0; db < 2; ++db) {
        __syncthreads();
#pragma unroll
        for (int i = 0; i < 16; ++i) oW[(w * 16 + i) * 64 + lane] = o[db][i];
        __syncthreads();
        float Mx = NEG_INF;
#pragma unroll
        for (int ww = 0; ww < 8; ++ww) Mx = fmaxf(Mx, mW[ww * 32 + col]);
        const float Ms = Mx == NEG_INF ? 0.f : Mx; float L = 0.f, sc[8];
#pragma unroll
        for (int ww = 0; ww < 8; ++ww) { sc[ww] = __expf(mW[ww * 32 + col] - Ms); L += lW[ww * 32 + col] * sc[ww]; }
        const float invL = L > 0.f ? 1.f / L : 0.f;
        if (STORE_ML && db == 0 && w == 0 && lane < 32) { ML[col] = Ms; ML[32 + col] = invL; }
#pragma unroll
        for (int s2 = 0; s2 < 2; ++s2) { const int s = 2 * w + s2; float a = 0.f;
#pragma unroll
            for (int ww = 0; ww < 8; ++ww) a += oW[(ww * 16 + s) * 64 + lane] * sc[ww];
            outL[(db * 16 + s) * 64 + lane] += gate * a * invL; }
    }
    __syncthreads();
}
__device__ __forceinline__ void nsa_sample_unit(Frame& F, int su) {
    const int b = su >> 2, kvh = su & 3, lane = lane_id(), w = F.wave, tid = w * 64 + lane, r = lane & 31, h = lane >> 5;
    const int qi = r & 7, gq = r >> 3; const bool colok = r < 24; const int gg = colok ? gq : 0, head = kvh * 3 + gg, qpos = PAST + qi, row = MP + b * TS + qi;
    const float slope = head < 8 ? exp2f(-(float)(head + 1)) : exp2f(-((float)(head - 8) + 0.5f));
    LAS bf16* Ks = (LAS bf16*)(F.lds + SU_K); LAS bf16* VTs = (LAS bf16*)(F.lds + SU_VT);
    LAS float* outL = (LAS float*)(F.lds + SU_OUT); LAS float* ML = (LAS float*)(F.lds + SU_ML); LAS float* impL = (LAS float*)(F.lds + SU_IMP);
    volatile LAS unsigned char* selL = (volatile LAS unsigned char*)(F.lds + SU_SEL); volatile LAS int* list = (volatile LAS int*)(F.lds + SU_LIST);
    LAS bf16* Ql = (LAS bf16*)(F.lds + SU_Q) + lane * 8;
    const bf16* prow = F.PROJ + (size_t)row * NINB_PAD;
    __syncthreads();
    if (w == 0) {
#pragma unroll
        for (int s = 0; s < 4; ++s) *(LAS v4u*)(Ql + s * 512) = qscale8(*(const v4u*)(prow + head * 64 + 16 * s + 8 * h)); }
    for (int i = tid; i < 2048; i += 512) outL[i] = 0.f;
    for (int i = tid; i < 8 * 132; i += 512) impL[i] = 0.f;
    float gate[3];
#pragma unroll
    for (int j = 0; j < 3; ++j) gate[j] = sigmoidf_(bf2f(prow[CONV + head * 3 + j]));
    float m, l; f32x16 o[2];
    m = NEG_INF; l = 0.f; zero16(o[0]); zero16(o[1]);
    for (int ch = 0; ch < 2; ++ch) {
        __syncthreads(); su_stage<0>(F, b, kvh, ch, tid, list, 0); __syncthreads();
        const float fd0 = (float)(qpos - 31 - 16 * (ch * 256 + 32 * w + 4 * h));
        if (__any(colok && fd0 >= 0.f)) attn_blk<1, 512>(Ks + 32 * w * KP, VTs + 32 * w, SU_VTP, Ql, slope, fd0, colok, m, l, o, r, h);
    }
    su_merge<true>(F, w, lane, m, l, o, gate[0]);
    for (int ch = 0; ch < 2; ++ch) {
        __syncthreads(); su_stage<0>(F, b, kvh, ch, tid, list, 0); __syncthreads();
        const float fd0 = (float)(qpos - 31 - 16 * (ch * 256 + 32 * w + 4 * h));
        if (__any(colok && fd0 >= 0.f)) { f32x16 acc; zero16(acc);
#pragma unroll
            for (int s = 0; s < 4; ++s) acc = MFMA32(*(const LAS bf16x8*)(Ks + (32 * w + r) * KP + 16 * s + 8 * h), *(const LAS bf16x8*)(Ql + 512 * s), acc);
            const float Ms = ML[r], invL = ML[32 + r];
#pragma unroll
            for (int a = 0; a < 4; ++a) { float v = 0.f;
#pragma unroll
                for (int i2 = 0; i2 < 4; ++i2) { const int i = 4 * a + i2; const float dist = fd0 - 16.f * (float)((i & 3) + 8 * (i >> 2)); v += (colok && dist >= 0.f) ? __expf(acc[i] - slope * dist - Ms) * invL : 0.f; }
                const int base_ = (lane & 32) | qi;
                const float t0 = __shfl(v, base_), t1 = __shfl(v, base_ + 8), t2 = __shfl(v, base_ + 16);
                if (gq == 0) impL[qi * 132 + ch * 64 + 8 * w + 2 * a + h] = (t0 + t1) + t2; } }
    }
    __syncthreads();
    { const int cur = qpos >> 6;
      float mine[3];
#pragma unroll
      for (int jj = 0; jj < 3; ++jj) { const int sb = lane + 64 * jj; mine[jj] = NEG_INF;
          if (sb < 129) { const bool forced = sb == 0 || sb == cur || sb == cur - 1; mine[jj] = forced ? 1e4f : impL[w * 132 + sb]; } }
      LDS_WAIT();
#pragma unroll
      for (int jj = 0; jj < 3; ++jj) { const int sb = lane + 64 * jj; if (sb < 129) impL[w * 132 + sb] = mine[jj]; }
      LDS_WAIT();
#pragma unroll
      for (int jj = 0; jj < 3; ++jj) { const int sb = lane + 64 * jj;
          if (sb < 129) { int cnt = 0; for (int j = 0; j < 129; ++j) { const float ot = impL[w * 132 + j]; cnt += (ot > mine[jj] || (ot == mine[jj] && j < sb)) ? 1 : 0; }
              selL[w * 132 + sb] = cnt < 16 ? 1 : 0; } } }
    __syncthreads();
    if (w == 0) { int base = 0;
#pragma unroll
        for (int jj = 0; jj < 3; ++jj) { const int sb = lane + 64 * jj; bool any = false;
            if (sb < 129) { for (int q = 0; q < 8; ++q) any = any || selL[q * 132 + sb] != 0; }
            const unsigned long long mk = __ballot(any);
            if (any) list[base + __popcll(mk & ((1ull << lane) - 1ull))] = sb;
            base += __popcll(mk); }
        if (lane == 0) list[131] = base; }
    __syncthreads();
    const int count = list[131];
    m = NEG_INF; l = 0.f; zero16(o[0]); zero16(o[1]);
    for (int ch = 0; ch * 4 < count; ++ch) {
        __syncthreads(); su_stage<1>(F, b, kvh, ch, tid, list, count); __syncthreads();
        const int e = ch * 4 + (w >> 1);
        if (e < count) { const int sb = list[e]; const bool ok = colok && selL[qi * 132 + sb] != 0; const float fd0 = (float)(qpos - (64 * sb + 32 * (w & 1) + 4 * h));
            if (__any(ok && fd0 >= 0.f)) attn_blk<2, 512>(Ks + 32 * w * KP, VTs + 32 * w, SU_VTP, Ql, slope, fd0, ok, m, l, o, r, h); }
    }
    su_merge<false>(F, w, lane, m, l, o, gate[1]);
    m = NEG_INF; l = 0.f; zero16(o[0]); zero16(o[1]);
    for (int ch = 0; ch < 3; ++ch) {
        __syncthreads(); su_stage<2>(F, b, kvh, ch, tid, list, 0); __syncthreads();
        const float fd0 = (float)(qpos - (PAST - 512 + ch * 256 + 32 * w + 4 * h));
        if (__any(colok && fd0 >= 0.f && fd0 - 27.f <= 512.f)) attn_blk<3, 512>(Ks + 32 * w * KP, VTs + 32 * w, SU_VTP, Ql, slope, fd0, colok, m, l, o, r, h);
    }
    su_merge<false>(F, w, lane, m, l, o, gate[2]);
    if (colok) {
#pragma unroll
        for (int db = 0; db < 2; ++db)
#pragma unroll
            for (int s2 = 0; s2 < 2; ++s2) { const int s = 2 * w + s2, d = db * 32 + (s & 3) + 8 * (s >> 2) + 4 * h;
                F.Y[(size_t)row * D + head * 64 + d] = (bf16)f2bf(outL[(db * 16 + s) * 64 + lane]); } }
    __syncthreads();
}

__device__ __forceinline__ void nsa_phase(Frame& F, int l) {
#if NSA_NAIVE
    LAS float* wl = (LAS float*)F.lds + F.wave * 2304;
    const int gw = F.vcu * NWAVES + F.wave, NGW = F.G * NWAVES;
    for (int task = gw; task < MS * 4; task += NGW) { const int kvh = task & 3, r = task >> 2; nsa_task<true>(F, r >> 3, r & 7, kvh, wl); }
    for (int task = gw; task < MP * 4; task += NGW) { const int kvh = task & 3, r = task >> 2; nsa_task<false>(F, r >> 12, r & 4095, kvh, wl); }
    __syncthreads();
#else
    for (int rep = 0; rep < REP_PNSA; ++rep)
    for (int unit = F.vcu; unit < 256; unit += F.G) { Frame F2 = mkframe(F.lds, F.wave); nsa_prompt_unit(F2, 255 - unit); }
    unsigned* ctr = (unsigned*)(F.ws + WS_CTL) + CW_QUEUE + l;
    volatile LAS int* qid = (volatile LAS int*)(F.lds + SU_QID);
    for (;;) { __syncthreads(); if (F.wave == 0 && lane_id() == 0) *qid = (int)atomicAdd(ctr, 1u); __syncthreads(); const int su = *qid; if (su >= BS * 4 * REP_SNSA) break;
        Frame F2 = mkframe(F.lds, F.wave); nsa_sample_unit(F2, su % (BS * 4)); }
#endif
}
__device__ __forceinline__ void final_phase(Frame& F, const float* g_final) {
    const int gw = F.vcu * NWAVES + F.wave, NGW = F.G * NWAVES, lane = F.lane;
    f32x4 g[4];
#pragma unroll
    for (int j = 0; j < 4; ++j) g[j] = *(const f32x4*)(g_final + j * 256 + lane * 4);
    for (int r = gw; r < M; r += 2 * NGW) {
        const int r2 = r + NGW; const bool two = r2 < M; const int rb = two ? r2 : r;
        const u64 q0 = F.rs[8 * M + r], q1 = F.rs[8 * M + rb];
        v2u xw[2][4];
#pragma unroll
        for (int j = 0; j < 4; ++j) { xw[0][j] = *(const v2u*)(F.XB + (size_t)r * D + j * 256 + lane * 4); xw[1][j] = *(const v2u*)(F.XB + (size_t)rb * D + j * 256 + lane * 4); }
        __builtin_amdgcn_sched_barrier(0);
#pragma unroll
        for (int i = 0; i < 2; ++i) if (i == 0 || two) { const int rr = i ? r2 : r; const float rstd = rsqrtf(from_fx(i ? q1 : q0) * (1.f / D) + RMS_EPS);
            float* dst = rr < MP ? F.out + OFF_YP + (size_t)rr * D : F.out + OFF_YS + (size_t)(rr - MP) * D;
#pragma unroll
            for (int j = 0; j < 4; ++j) { const f32x4 v = {bflo(xw[i][j].x), bfhi(xw[i][j].x), bflo(xw[i][j].y), bfhi(xw[i][j].y)};
                *(f32x4*)(dst + j * 256 + lane * 4) = v * rstd * g[j]; } } }
}

#define IN(k) (lo <= (k) && (k) < hi)
#define SEAM(k) do { if (!MK_PER_PHASE && IN(k) && IN((k) + 1)) { KArgs ka_ = (KArgs)__builtin_amdgcn_kernarg_segment_ptr(); asm volatile("" : "+s"(ka_)); \
        XcdBarrier bar_; bar_.bar = (unsigned*)(ka_->ws + WS_CTL) + CW_BAR; bar_.x = xb_xcc_id(); bar_.st = MISC + 8; bar_.tid = wv * 64 + lane_id(); xcd_barrier(bar_); } } while (0)
#define RUN_CMP_GEMM(P0, NP) do { EpiHid E_{(bf16*)(F.ws + WS_HIDB), (const float*)(F.ws + WS_CBIAS)}; pg8::Gemm g_{(const pg8::bf16_t*)(F.ws + WS_CMPA), (const pg8::bf16_t*)(F.ws + WS_WCMP), (int)(2 * NR), 512, 1024}; \
        CmpOrder S_{(P0), (NP), F.G, (int)blockIdx.x}; pg8::gemm_phase<EpiHid, CmpOrder, true, true>(F.lds, g_, S_, E_, F.tid); } while (0)
#define RUN_GEMM(EpiT, E, Ap, Bp, Mv, Nv, Kv) do { pg8::Gemm g_{(const pg8::bf16_t*)(Ap), (const pg8::bf16_t*)(Bp), (Mv), (Nv), (Kv)}; pg8::StaticOrder S_; S_.init((Mv), (Nv), F.G, (int)blockIdx.x); \
        pg8::gemm_phase<EpiT, pg8::StaticOrder, true, true>(F.lds, g_, S_, E, F.tid); } while (0)


template <int l> __device__ __forceinline__ void run_layer(LAS unsigned char* const lds, volatile LAS unsigned* const MISC, const int wv, const int lo, const int hi) {
        constexpr int pb = 2 + 7 * l;
        if (IN(pb)) for (int rep = 0; rep < REP_INP; ++rep) {
            if (l == 0) { Frame F = mkframe(lds, wv); cmp_sample_fused_phase(F); }
            Frame F = mkframe(lds, wv);
            if (l < 2) { EpiInA E{F.PROJ, NINA, F.rs + (2 * l) * M}; RUN_GEMM(EpiInA, E, F.XB, (bf16*)(F.ws + WS_WINA) + (size_t)l * NINA * D, M, NINA, D);
                if (l == 0) { Frame F3 = mkframe(lds, wv); EpiMemKV E2{F3.out, F3.rs + 9 * M, (bf16*)(F3.ws + WS_MKB), (bf16*)(F3.ws + WS_MVT)};
                    pg8::Gemm g2{(const pg8::bf16_t*)F3.MEMB, (const pg8::bf16_t*)(F3.ws + WS_WMKV), 1024, 2048, D}; pg8::StaticOrder S2; S2.init(1024, 2048, F3.G, (int)((blockIdx.x + F3.G - 138u) % F3.G));
                    pg8::gemm_phase<EpiMemKV, pg8::StaticOrder, true, true>(F3.lds, g2, S2, E2, F3.tid); } }
            else { EpiInB E{F.PROJ, F.KVB, F.out, F.rs + (2 * l) * M, (bf16*)(F.ws + WS_VTB), (bf16*)(F.ws + WS_CMPA), (bf16*)(F.ws + WS_KTB)}; RUN_GEMM(EpiInB, E, F.XB, F.ws + (l == 2 ? WS_WINB2 : WS_WINB3), M, (l == 2 ? NB2 : NINB_PAD), D); }
        }
        SEAM(pb);
        if (l == 2) {
            if (IN(pb + 1)) { { Frame F = mkframe(lds, wv); RUN_CMP_GEMM(0, 16); }
                              { Frame F2 = mkframe(lds, wv); memattn_mfma_phase(F2, l, NINB_PAD, CONV + 36, (unsigned*)(F2.ws + WS_CTL) + CW_QUEUE + 8 + l); }
                              { Frame F2 = mkframe(lds, wv); win_copy_phase(F2); }
                              { Frame F2 = mkframe(lds, wv); l3_weights_phase(F2); } }
            SEAM(pb + 1);
            if (IN(pb + 2)) for (int rep = 0; rep < REP_MISC; ++rep) { Frame F = mkframe(lds, wv); ctx2_mfma_phase(F, false); }
            SEAM(pb + 2);
        }
        if (IN(pb + 3)) { Frame F = mkframe(lds, wv);
#if MEM_NAIVE
            if (l < 2) { conv_phase(F, l, (const float*)F.ka->in[11]); memattn_phase(F, l, NINA, 3 * CONV); }
            else { nsa_phase(F, l); memattn_phase(F, l, NINB_PAD, CONV + 36); }
#else
            if (l < 2) { for (int rep = 0; rep < REP_MIX; ++rep) conv_phase(F, l, (const float*)F.ka->in[11]); } else { nsa_phase(F, l); }
            if (l != 2) for (int rep = 0; rep < REP_MIX; ++rep) { Frame F2 = mkframe(lds, wv); memattn_mfma_phase(F2, l, l < 2 ? NINA : NINB_PAD, l < 2 ? 3 * CONV : CONV + 36, l < 2 ? nullptr : (unsigned*)(F2.ws + WS_CTL) + CW_QUEUE + 8 + l); }
            if (l == 1) { Frame F2 = mkframe(lds, wv); ctx2_mfma_phase(F2, true); }
#endif
        }
        SEAM(pb + 3);
        if (IN(pb + 4)) { { Frame F = mkframe(lds, wv); EpiRes E{F.XB, F.rs + (2 * l + 1) * M}; RUN_GEMM(EpiRes, E, F.Y, (bf16*)(F.ws + WS_WO) + (size_t)l * D * D, MP, D, D); }
                          { Frame F = mkframe(lds, wv); sample_res_gemm(F, F.Y, D, (bf16*)(F.ws + WS_WO) + (size_t)l * D * D, F.rs + (2 * l + 1) * M); } }
        SEAM(pb + 4);
        if (IN(pb + 5)) for (int rep = 0; rep < REP_GU; ++rep) { Frame F = mkframe(lds, wv); EpiGU E{F.ACT, F.rs + (2 * l + 1) * M}; RUN_GEMM(EpiGU, E, F.XB, (bf16*)(F.ws + WS_WGU) + (size_t)l * NGU * D, M, NGU, D); }
        SEAM(pb + 5);
        if (l == 3 && FUSE_FINAL && !MK_PER_PHASE && (int)gridDim.x == 256) {
            if (IN(pb + 6)) { { Frame F = mkframe(lds, wv); EpiFinal E{F.XB, F.rs + 8 * M, F.out, (const float*)F.ka->in[27], (unsigned*)(F.ws + WS_CTL) + CW_FIN};
                                RUN_GEMM(EpiFinal, E, F.ACT, (bf16*)(F.ws + WS_WDN) + (size_t)l * D * FF, MP, D, FF); }
                              { Frame F = mkframe(lds, wv); sample_res_gemm<true>(F, F.ACT, FF, (bf16*)(F.ws + WS_WDN) + (size_t)l * D * FF, F.rs + 8 * M, (const float*)F.ka->in[27]); } }
            return; }
        if (IN(pb + 6)) { { Frame F = mkframe(lds, wv); EpiRes E{F.XB, F.rs + (2 * l + 2) * M}; RUN_GEMM(EpiRes, E, F.ACT, (bf16*)(F.ws + WS_WDN) + (size_t)l * D * FF, MP, D, FF); }
                          { Frame F = mkframe(lds, wv); sample_res_gemm(F, F.ACT, FF, (bf16*)(F.ws + WS_WDN) + (size_t)l * D * FF, F.rs + (2 * l + 2) * M); } }
        SEAM(pb + 6);
    }

__global__ void __launch_bounds__(NWAVES * 64, 2) yoco_fwd(Args a_unused) {
    extern __shared__ __attribute__((aligned(16))) unsigned char lds_raw[];
    LAS unsigned char* const lds = (LAS unsigned char*)lds_raw;
    volatile LAS unsigned* MISC = (volatile LAS unsigned*)(lds + MISC_OFF);
    const int wv = __builtin_amdgcn_readfirstlane((int)threadIdx.x >> 6);
    if (threadIdx.x < 32) MISC[threadIdx.x] = 0u;
    __syncthreads();
    int lo, hi;
    { KArgs ka = (KArgs)__builtin_amdgcn_kernarg_segment_ptr(); lo = ka->ph_lo; hi = ka->ph_hi;
      if (!MK_PER_PHASE) (void)xcd_barrier_post((unsigned*)(ka->ws + WS_CTL) + CW_BAR, MISC + 8, (int)threadIdx.x); }
    if (IN(0)) { for (int rep = 0; rep < REP_PRO; ++rep) { Frame F = mkframe(lds, wv); prologue(F); __syncthreads(); } }
    SEAM(0);
    run_layer<0>(lds, MISC, wv, lo, hi); run_layer<1>(lds, MISC, wv, lo, hi); run_layer<2>(lds, MISC, wv, lo, hi); run_layer<3>(lds, MISC, wv, lo, hi);
    if (FUSE_FINAL && !MK_PER_PHASE && (int)gridDim.x == 256) return;
    if (IN(NPH - 1)) for (int rep = 0; rep < REP_MISC; ++rep) { Frame F = mkframe(lds, wv); final_phase(F, (const float*)F.ka->in[27]); }
}

extern "C" void kernel_launch(void* const* d_in, const int* in_sizes, int n_in, void* d_out, int out_size, void* d_ws, size_t ws_size, hipStream_t stream) {
    static int grid = 0;
    if (grid == 0) {
        if (n_in != 28 || out_size != (int)OUT_TOTAL || ws_size < WS_END) { fprintf(stderr, "kernel_launch: unexpected shapes: n_in %d out %d ws %zu (need %zu)\n", n_in, out_size, ws_size, (size_t)WS_END); grid = -1; return; }
        int dev = 0, cus = 0, per_cu = 0;
        if (hipGetDevice(&dev) != hipSuccess || hipDeviceGetAttribute(&cus, hipDeviceAttributeMultiprocessorCount, dev) != hipSuccess) { grid = -1; return; }
        if (hipFuncSetAttribute((const void*)yoco_fwd, hipFuncAttributeMaxDynamicSharedMemorySize, LDS_BYTES) != hipSuccess) { fprintf(stderr, "kernel_launch: hipFuncSetAttribute failed\n"); grid = -1; return; }
        if (hipOccupancyMaxActiveBlocksPerMultiprocessor(&per_cu, (const void*)yoco_fwd, NWAVES * 64, LDS_BYTES) != hipSuccess || per_cu < 1) fprintf(stderr, "kernel_launch: occupancy query reports %d\n", per_cu);
        (void)hipGetLastError();
        grid = cus;
    }
    if (grid < 0) return;
    if (hipMemsetAsync((char*)d_ws + WS_CTL, 0, CTL_BYTES, stream) != hipSuccess) return;
    Args a{};
    for (int i = 0; i < 28; ++i) a.in[i] = d_in[i];
    a.out = (float*)d_out; a.ws = (unsigned char*)d_ws; a.li = 0; a.pad = 0;
#if MK_PER_PHASE
    for (int p = 0; p < NPH; ++p) {
        const int k = (p - 2) % 7;
        if (p >= 2 && p < NPH - 1 && (k == 1 || k == 2) && (p - 2) / 7 != 2) continue;
        a.ph_lo = p; a.ph_hi = p + 1;
        hipLaunchKernelGGL(yoco_fwd, dim3(grid), dim3(NWAVES * 64), LDS_BYTES, stream, a);
    }
#else
    a.ph_lo = 0; a.ph_hi = NPH;
    hipLaunchKernelGGL(yoco_fwd, dim3(grid), dim3(NWAVES * 64), LDS_BYTES, stream, a);
#endif
    const hipError_t le = hipPeekAtLastError();
    if (le != hipSuccess) fprintf(stderr, "kernel_launch: launch failed: %s\n", hipGetErrorName(le));
}
```

```cpp
#include <hip/hip_runtime.h>
#include <cstdio>
#include <cstdint>
namespace pg8 {
#define PG8_LAS __attribute__((address_space(3)))
typedef unsigned short bf16_t;
typedef short bf16x8 __attribute__((ext_vector_type(8)));
typedef float f32x4 __attribute__((ext_vector_type(4)));
typedef unsigned u32x4 __attribute__((ext_vector_type(4)));
constexpr int BM = 256, BK = 64, HALF = 128, HTB = HALF * BK * 2  , STAGE_BYTES = 8 * HTB, NXCD = 8, WGM = 8;

__host__ __device__ __forceinline__ int lds_byte(int r, int c) { const int st = (r >> 4) * 2 + (c >> 5), rr = r & 15, cc = c & 31, ob = rr * 64 + cc * 2; return st * 1024 + (ob ^ (((ob >> 9) & 1) << 5)); }
__host__ __device__ __forceinline__ void stage_rc(int b, int& R, int& C) { const int st = b / 1024, sb = b % 1024, swz = sb ^ (((sb >> 9) & 1) << 5); R = (st >> 1) * 16 + swz / 64; C = (st & 1) * 32 + (swz % 64) / 2; }
__host__ __device__ __forceinline__ int perm32(int rho) { const int n = rho >> 4, i = rho & 15; return 8 * (i >> 2) + 4 * n + (i & 3); }

struct Unit { int pm, pn; };
struct Gemm { const bf16_t* A; const bf16_t* Bt; int M, N, K; };
struct StaticOrder {
    int nM, nN, nwg, G, c;
    __host__ __device__ void init(int M, int N, int G_, int c_) { nM = M / BM; nN = N / BM; nwg = nM * nN; G = G_; c = c_; }
    __host__ __device__ bool next(int i, Unit& u) const {
        const long L = (long)i * G + c; if (L >= nwg) return false;
        int wgid = (int)L; { const int q = nwg / NXCD, r = nwg % NXCD, xcd = wgid % NXCD, off = wgid / NXCD; wgid = (xcd < r ? xcd * (q + 1) : r * (q + 1) + (xcd - r) * q) + off; }
        const int nig = WGM * nN, gid = wgid / nig, fm = gid * WGM, gsz = (nM - fm) < WGM ? (nM - fm) : WGM;
        u.pm = fm + ((wgid % nig) % gsz); u.pn = (wgid % nig) / gsz; return true;
    }
    __device__ __forceinline__ void a_ready(const Unit&) const {}
    __device__ __forceinline__ void done(const Unit&) const {}
};

__device__ __forceinline__ unsigned cvt_pk_bf16(float lo, float hi) { unsigned r; asm volatile("v_cvt_pk_bf16_f32 %0, %1, %2" : "=v"(r) : "v"(lo), "v"(hi)); return r; }
typedef float f32x2 __attribute__((ext_vector_type(2)));

template <class Epi, class Sched, bool ALIGN_EPI = false, bool SP2 = false>
__device__ __forceinline__ void gemm_phase(PG8_LAS unsigned char* lds, const Gemm g, const Sched& S, const Epi& E, const int tid) {
    const int wid = __builtin_amdgcn_readfirstlane(tid >> 6), lane = tid & 63, wr = wid >> 2, wc = wid & 3, fr = lane & 15, fq = lane >> 4;
    const int K = g.K, nt = K / BK;
    unsigned voffA[2], voffB[2];
#pragma unroll
    for (int i = 0; i < 2; ++i) { int R, C; stage_rc(tid * 16 + i * 8192, R, C); const int Rb = Epi::PERM ? ((R & ~31) + perm32(R & 31)) : R;
        voffA[i] = (unsigned)(R * K + C) * 2u; voffB[i] = (unsigned)(Rb * K + C) * 2u; }
    const size_t kstep = (size_t)(BK * 2);
    const size_t hstep = (size_t)HALF * K * 2;
    const size_t tstep = 2 * hstep;
    const unsigned ldsw = (unsigned)wid * 1024u;
    const int aoff = lds_byte(wr * 64 + fr, fq * 8), boff = lds_byte(wc * 32 + fr, fq * 8);
#define PG8_SA(b, h) (((b) * 2 + (h)) * HTB)
#define PG8_SB(b, h) ((4 + (b) * 2 + (h)) * HTB)
#define PG8_STAGE(bufoff, gbase, voff) do { _Pragma("unroll") for (int _i = 0; _i < 2; ++_i) \
        __builtin_amdgcn_global_load_lds((const unsigned*)((const char*)(gbase) + (voff)[_i]), (PG8_LAS unsigned*)(lds + (bufoff) + ldsw + _i * 8192), 16, 0, 0); } while (0)
#define PG8_LDA(dst, b, h) do { _Pragma("unroll") for (int m = 0; m < 4; ++m) _Pragma("unroll") for (int k = 0; k < 2; ++k) dst[m][k] = *(const PG8_LAS bf16x8*)(lds + PG8_SA(b, h) + aoff + m * 2048 + k * 1024); } while (0)
#define PG8_LDB(dst, b, h) do { _Pragma("unroll") for (int n = 0; n < 2; ++n) _Pragma("unroll") for (int k = 0; k < 2; ++k) dst[n][k] = *(const PG8_LAS bf16x8*)(lds + PG8_SB(b, h) + boff + n * 2048 + k * 1024); } while (0)
#define PG8_MMA(ai, bj, At, Bt) do { __builtin_amdgcn_s_setprio(1); _Pragma("unroll") for (int m = 0; m < 4; ++m) _Pragma("unroll") for (int n = 0; n < 2; ++n) _Pragma("unroll") for (int k = 0; k < 2; ++k) \
        acc[ai][bj][m][n] = __builtin_amdgcn_mfma_f32_16x16x32_bf16(Bt[n][k], At[m][k], acc[ai][bj][m][n], 0, 0, 0); __builtin_amdgcn_s_setprio(0); } while (0)
#define PG8_WAIT_V(n) asm volatile("s_waitcnt vmcnt(" #n ")" ::: "memory")
#define PG8_WAIT_L(n) asm volatile("s_waitcnt lgkmcnt(" #n ")" ::: "memory")
#define PG8_BAR __builtin_amdgcn_s_barrier()
#define PG8_SCHED __builtin_amdgcn_sched_barrier(0)
    Unit cur, nxt; int ui = 0;
    if (!S.next(0, cur)) return;
    f32x4 acc[2][2][4][2];
#pragma unroll
    for (int a = 0; a < 2; ++a)
#pragma unroll
        for (int b = 0; b < 2; ++b)
#pragma unroll
            for (int m = 0; m < 4; ++m)
#pragma unroll
                for (int n = 0; n < 2; ++n) acc[a][b][m][n] = (f32x4){0.f, 0.f, 0.f, 0.f};
    bf16x8 At[4][2], B0[2][2], B1[2][2];
    unsigned long long pre_[8];
    const char* cA = (const char*)g.A + (size_t)cur.pm * tstep; const char* cB = (const char*)g.Bt + (size_t)cur.pn * tstep;
    S.a_ready(cur);
    if constexpr (SP2) {
        PG8_STAGE(PG8_SB(0, 0), cB, voffB); PG8_STAGE(PG8_SB(0, 1), cB + hstep, voffB); PG8_STAGE(PG8_SA(0, 0), cA, voffA); PG8_STAGE(PG8_SA(0, 1), cA + hstep, voffA);
        if (wr == 1) PG8_BAR;
        PG8_WAIT_V(2); PG8_BAR;
        PG8_STAGE(PG8_SB(1, 0), cB + kstep, voffB); PG8_STAGE(PG8_SA(1, 0), cA + kstep, voffA); PG8_STAGE(PG8_SB(1, 1), cB + hstep + kstep, voffB);
        PG8_WAIT_V(6); PG8_BAR;
    } else {
        PG8_STAGE(PG8_SB(0, 0), cB, voffB); PG8_STAGE(PG8_SA(0, 0), cA, voffA); PG8_STAGE(PG8_SB(0, 1), cB + hstep, voffB); PG8_STAGE(PG8_SA(0, 1), cA + hstep, voffA);
        if (wr == 1) PG8_BAR;
        PG8_WAIT_V(4); PG8_BAR;
        PG8_STAGE(PG8_SB(1, 0), cB + kstep, voffB); PG8_STAGE(PG8_SA(1, 0), cA + kstep, voffA); PG8_STAGE(PG8_SB(1, 1), cB + hstep + kstep, voffB);
        PG8_WAIT_V(6); PG8_BAR;
    }
    for (;;) {
        const bool has_next = S.next(ui + 1, nxt);
        const char* nA = has_next ? (const char*)g.A + (size_t)nxt.pm * tstep : cA; const char* nB = has_next ? (const char*)g.Bt + (size_t)nxt.pn * tstep : cB;
        for (int t = 0; t < nt; t += 2) {
            const bool last = (t == nt - 2);
            const char* a1 = cA + (size_t)(t + 1) * kstep;
            const char* a2 = last ? nA : cA + (size_t)(t + 2) * kstep; const char* b2 = last ? nB : cB + (size_t)(t + 2) * kstep;
            const char* a3 = a2 + kstep; const char* b3 = b2 + kstep;
            if (last && has_next) S.a_ready(nxt);
            if constexpr (Epi::PRE) { if (last) E.pre(cur, wr, fr, pre_); }
            if constexpr (SP2) {
            PG8_LDB(B0, 0, 0); PG8_LDB(B1, 0, 1); PG8_SCHED; PG8_LDA(At, 0, 0); PG8_STAGE(PG8_SA(1, 1), a1 + hstep, voffA);
            PG8_WAIT_V(8); PG8_WAIT_L(0); PG8_BAR; PG8_MMA(0, 0, At, B0); PG8_MMA(0, 1, At, B1); PG8_BAR; PG8_SCHED;
            PG8_LDA(At, 0, 1); PG8_STAGE(PG8_SB(0, 0), b2, voffB); PG8_STAGE(PG8_SB(0, 1), b2 + hstep, voffB); PG8_STAGE(PG8_SA(0, 0), a2, voffA);
            PG8_WAIT_V(8); PG8_WAIT_L(0); PG8_BAR; PG8_MMA(1, 0, At, B0); PG8_MMA(1, 1, At, B1); PG8_BAR; PG8_SCHED;
            PG8_LDB(B0, 1, 0); PG8_LDB(B1, 1, 1); PG8_SCHED; PG8_LDA(At, 1, 0); PG8_STAGE(PG8_SA(0, 1), a2 + hstep, voffA);
            PG8_WAIT_V(8); PG8_WAIT_L(0); PG8_BAR; PG8_MMA(0, 0, At, B0); PG8_MMA(0, 1, At, B1); PG8_BAR; PG8_SCHED;
            PG8_LDA(At, 1, 1); PG8_STAGE(PG8_SB(1, 0), b3, voffB); PG8_STAGE(PG8_SB(1, 1), b3 + hstep, voffB); PG8_STAGE(PG8_SA(1, 0), a3, voffA);
            PG8_WAIT_V(8); PG8_WAIT_L(0); PG8_BAR; PG8_MMA(1, 0, At, B0); PG8_MMA(1, 1, At, B1); PG8_BAR; PG8_SCHED;
            } else {
            PG8_LDB(B0, 0, 0); PG8_SCHED; PG8_LDA(At, 0, 0); PG8_STAGE(PG8_SA(1, 1), a1 + hstep, voffA);
            PG8_WAIT_L(8); PG8_BAR; PG8_WAIT_L(0); PG8_MMA(0, 0, At, B0); PG8_BAR; PG8_SCHED;
            PG8_LDB(B1, 0, 1); PG8_STAGE(PG8_SB(0, 0), b2, voffB);
            PG8_BAR; PG8_WAIT_L(0); PG8_MMA(0, 1, At, B1); PG8_BAR;
            PG8_LDA(At, 0, 1); PG8_STAGE(PG8_SA(0, 0), a2, voffA);
            PG8_BAR; PG8_WAIT_L(0); PG8_MMA(1, 0, At, B0); PG8_BAR; PG8_SCHED;
            PG8_STAGE(PG8_SB(0, 1), b2 + hstep, voffB);
            PG8_WAIT_V(6); PG8_BAR; PG8_MMA(1, 1, At, B1); PG8_BAR;
            PG8_LDB(B0, 1, 0); PG8_SCHED; PG8_LDA(At, 1, 0); PG8_STAGE(PG8_SA(0, 1), a2 + hstep, voffA);
            PG8_WAIT_L(8); PG8_BAR; PG8_WAIT_L(0); PG8_MMA(0, 0, At, B0); PG8_BAR; PG8_SCHED;
            PG8_LDB(B1, 1, 1); PG8_STAGE(PG8_SB(1, 0), b3, voffB);
            PG8_BAR; PG8_WAIT_L(0); PG8_MMA(0, 1, At, B1); PG8_BAR;
            PG8_LDA(At, 1, 1); PG8_STAGE(PG8_SA(1, 0), a3, voffA);
            PG8_BAR; PG8_WAIT_L(0); PG8_MMA(1, 0, At, B0); PG8_BAR; PG8_SCHED;
            PG8_STAGE(PG8_SB(1, 1), b3 + hstep, voffB);
            PG8_WAIT_V(6); PG8_BAR; PG8_MMA(1, 1, At, B1); PG8_BAR;
            }
        }
        if constexpr (ALIGN_EPI) { if (wr == 0) PG8_BAR; }
        if constexpr (!Epi::AFTER_DRAIN) { if constexpr (Epi::PRE) E(acc, cur, wr, wc, fr, fq, pre_); else E(acc, cur, wr, wc, fr, fq); S.done(cur); }
        if (!has_next) break;
#pragma unroll
        for (int a = 0; a < 2; ++a)
#pragma unroll
            for (int b = 0; b < 2; ++b)
#pragma unroll
                for (int m = 0; m < 4; ++m)
#pragma unroll
                    for (int n = 0; n < 2; ++n) acc[a][b][m][n] = (f32x4){0.f, 0.f, 0.f, 0.f};
        cur = nxt; cA = nA; cB = nB; ++ui;
        if constexpr (ALIGN_EPI) { if (wr == 1) PG8_BAR; }
    }
    PG8_WAIT_V(0);
    if constexpr (!ALIGN_EPI) { if (wr == 0) PG8_BAR; }
    PG8_BAR;
    if constexpr (Epi::AFTER_DRAIN) { E.fused(acc, cur, wr, wc, fr, fq, lds, wid, lane); S.done(cur); }
#undef PG8_SA
#undef PG8_SB
#undef PG8_STAGE
#undef PG8_LDA
#undef PG8_LDB
#undef PG8_MMA
#undef PG8_WAIT_V
#undef PG8_WAIT_L
#undef PG8_BAR
#undef PG8_SCHED
}
}


#ifndef NSA_NAIVE
#define NSA_NAIVE 0
#endif
#ifndef MEM_NAIVE
#define MEM_NAIVE 0
#endif
#ifndef FUSE_FINAL
#define FUSE_FINAL 1
#endif
#ifndef STAG_SLEEP
#define STAG_SLEEP 0
#endif
#ifndef REP_MIX
#define REP_MIX 1
#endif
#ifndef REP_INP
#define REP_INP 1
#endif
#ifndef REP_GU
#define REP_GU 1
#endif
#ifndef REP_MISC
#define REP_MISC 1
#endif
#ifndef REP_WIN
#define REP_WIN 1
#endif
#ifndef REP_TOPK
#define REP_TOPK 1
#endif
#ifndef REP_RES
#define REP_RES 1
#endif
#ifndef REP_SNSA
#define REP_SNSA 1
#endif
#ifndef REP_PNSA
#define REP_PNSA 1
#endif
#ifndef REP_PRO
#define REP_PRO 1
#endif
#ifndef MK_PER_PHASE
#define MK_PER_PHASE 0
#endif
constexpr int NWAVES = 8;

constexpr int D = 1024, BP = 4, TP = 4096, BS = 32, TS = 8, MP = BP * TP, MS = BS * TS, M = MP + MS;
constexpr int PAST = 8192, NPAGES = 64;
constexpr int CONV = 768, NMEM = 256, NINA = 2560, NINB = 1060, NINB_PAD = 1280, NKV = 1536, NB2 = NINB_PAD + NKV;
constexpr int FF = 2816, NGU = 2 * FF;
constexpr int NCP = 255, NCS = 511;
constexpr int CHP = 256, CHS = 512;
constexpr float RMS_EPS = 1e-6f;
#define NEG_INF (-__builtin_inff())

constexpr size_t OFF_YP = 0, OFF_YS = OFF_YP + (size_t)MP * D, OFF_CSP = OFF_YS + (size_t)MS * D, OFF_CSS = OFF_CSP + 2 * BP * 2 * CONV,
                 OFF_MEMKV = OFF_CSS + 2 * BS * 2 * CONV, OFF_CMP_P = OFF_MEMKV + (size_t)4 * BP * NMEM * 512, OFF_SLC_P = OFF_CMP_P + (size_t)MP * 512,
                 OFF_WIN_P = OFF_SLC_P + (size_t)MP * 512, OFF_CMP_S = OFF_WIN_P + (size_t)BP * 512 * 512, OFF_SLC_S = OFF_CMP_S + (size_t)MS * 512,
                 OFF_WIN_S = OFF_SLC_S + (size_t)MS * 512, OUT_TOTAL = OFF_WIN_S + (size_t)BS * 512 * 512;
static_assert(OUT_TOTAL == 45723648, "output size");

constexpr size_t MiB = 1u << 20;
constexpr size_t al1(size_t x) { return (x + MiB - 1) / MiB * MiB; }
constexpr size_t WS_CTL = 0, CTL_BYTES = 2 * MiB;
constexpr size_t WS_WINA = CTL_BYTES;
constexpr size_t WS_WINB2 = WS_WINA + al1((size_t)2 * NINA * D * 2);
constexpr size_t WS_WINB3 = WS_WINB2 + al1((size_t)NB2 * D * 2);
constexpr size_t WS_WO = WS_WINB3 + al1((size_t)NINB_PAD * D * 2);
constexpr size_t WS_WGU = WS_WO + al1((size_t)4 * D * D * 2);
constexpr size_t WS_WDN = WS_WGU + al1((size_t)4 * NGU * D * 2);
constexpr size_t WS_WMKV = WS_WDN + al1((size_t)4 * D * FF * 2);
constexpr size_t WS_XS = WS_WMKV + al1((size_t)2048 * D * 2);
constexpr size_t WS_IMPS = WS_XS, WS_IMPM = WS_XS + (size_t)256 * 8 * 24 * 64 * 16;
static_assert(WS_IMPM + (size_t)256 * 8 * 12 * 64 * 4 <= WS_XS + (size_t)M * D * 4, "importance scratch fits the region");
constexpr size_t WS_XB = WS_XS + al1((size_t)M * D * 4);
constexpr size_t WS_PROJ = WS_XB + al1((size_t)M * D * 2);
constexpr size_t WS_Y = WS_PROJ + al1((size_t)M * NINA * 2);
constexpr size_t WS_ACT = WS_Y + al1((size_t)M * D * 2);
constexpr size_t WS_KVB = WS_ACT + al1((size_t)M * FF * 2);
constexpr size_t WS_MEMB = WS_KVB + al1((size_t)M * NKV * 2);
constexpr size_t WS_HID = WS_MEMB + al1((size_t)1024 * D * 2);
constexpr size_t N_CHUNKS = (size_t)BP * CHP + (size_t)BS * CHS;
constexpr size_t WS_CK = WS_HID + al1(N_CHUNKS * 4 * 2 * 256 * 4);
constexpr size_t WS_MKB = WS_CK + al1(N_CHUNKS * 2 * 4 * 64 * 4);
constexpr size_t WS_MVT = WS_MKB + al1((size_t)4 * 1024 * 256 * 2);
constexpr size_t WS_VTB = WS_MVT + al1((size_t)4 * 1024 * 256 * 2);
constexpr size_t WS_KTB = WS_VTB + al1((size_t)2 * MP * 256 * 2);
constexpr size_t WS_CKB = WS_KTB + al1((size_t)2 * MP * 256 * 2);
constexpr size_t WS_CVT = WS_CKB + al1((size_t)BP * 4 * 256 * 64 * 2);
constexpr size_t WS_OACC = WS_CVT + al1((size_t)BP * 4 * 256 * 64 * 2);
constexpr size_t NR = N_CHUNKS * 4;
constexpr size_t WS_CMPA = WS_OACC + al1((size_t)256 * 8 * 24 * 64 * 16);
constexpr size_t WS_WCMP = WS_CMPA + al1((size_t)2 * NR * 1024 * 2);
constexpr size_t WS_CBIAS = WS_WCMP + al1((size_t)512 * 1024 * 2);
constexpr size_t WS_W2T = WS_CBIAS + (MiB >> 1);
constexpr size_t WS_HIDB = WS_CBIAS + MiB;
constexpr size_t WS_END = WS_HIDB + al1((size_t)2 * NR * 256 * 2);
static_assert(NR % 256 == 0 && NR / 256 == 272, "compression GEMM panels");
constexpr int CW_BAR = 1024, N_BAR_REGIONS = 1, CW_QUEUE = 512;
constexpr int CW_RS = 16384;
constexpr int CW_RSM = CW_RS + 9 * M;
static_assert((size_t)CW_RS * 4 + (size_t)(9 * M + 1024) * 8 <= CTL_BYTES && CW_BAR + 3456 <= CW_RS, "CTL map");

constexpr int LDS_BYTES = 147456;
constexpr int MISC_OFF = LDS_BYTES - 128;

#define GAS __attribute__((address_space(1)))
#define LAS __attribute__((address_space(3)))
typedef unsigned short bf16;
typedef unsigned v4u __attribute__((ext_vector_type(4)));
typedef unsigned v2u __attribute__((ext_vector_type(2)));
typedef float f32x4 __attribute__((ext_vector_type(4)));
typedef short bf16x8 __attribute__((ext_vector_type(8)));
typedef GAS unsigned gu32;
#define LDS_WAIT() asm volatile("s_waitcnt lgkmcnt(0)" ::: "memory")
__device__ __forceinline__ unsigned f2bf(float f) { unsigned u = __builtin_bit_cast(unsigned, f); return (u + 0x7fffu + ((u >> 16) & 1u)) >> 16; }
__device__ __forceinline__ unsigned pk2(float lo, float hi) { return f2bf(lo) | (f2bf(hi) << 16); }
__device__ __forceinline__ float bf2f(unsigned b) { return __builtin_bit_cast(float, b << 16); }
__device__ __forceinline__ float bflo(unsigned w) { return __builtin_bit_cast(float, w << 16); }
__device__ __forceinline__ float bfhi(unsigned w) { return __builtin_bit_cast(float, w & 0xffff0000u); }
__device__ __forceinline__ float wave_sum(float v) {
#pragma unroll
    for (int o = 1; o < 64; o <<= 1) v += __shfl_xor(v, o);
    return v;
}
__device__ __forceinline__ float wave_max(float v) {
#pragma unroll
    for (int o = 1; o < 64; o <<= 1) v = fmaxf(v, __shfl_xor(v, o));
    return v;
}
typedef unsigned long long u64;
__device__ __forceinline__ u64 to_fx(float s) { return (u64)(s * 1048576.f + 0.5f); }
__device__ __forceinline__ float from_fx(u64 v) { return (float)v * (1.f / 1048576.f); }
__device__ __forceinline__ int lane_id() { int l; asm volatile("v_mbcnt_lo_u32_b32 %0, -1, 0\n\tv_mbcnt_hi_u32_b32 %0, -1, %0" : "=v"(l)); return l; }
__device__ __forceinline__ float sigmoidf_(float x) { return __builtin_amdgcn_rcpf(1.f + __builtin_amdgcn_exp2f(x * -1.4426950408889634f)); }
typedef float f32x16 __attribute__((ext_vector_type(16)));
typedef __bf16 bf16x2_t __attribute__((ext_vector_type(2)));
typedef float f32x2_t __attribute__((ext_vector_type(2)));
#define LOG2E 1.4426950408889634f
#define MFMA32(a, b, c) __builtin_amdgcn_mfma_f32_32x32x16_bf16((a), (b), (c), 0, 0, 0)
__device__ __forceinline__ unsigned cvtpk(float lo, float hi) { f32x2_t v = {lo, hi}; return __builtin_bit_cast(unsigned, __builtin_convertvector(v, bf16x2_t)); }
__device__ __forceinline__ int vpermk(int kk) { return (kk & ~12) | ((kk & 4) << 1) | ((kk & 8) >> 1); }
constexpr int KP = 72;
__device__ __forceinline__ void zero16(f32x16& v) {
#pragma unroll
    for (int i = 0; i < 16; ++i) v[i] = 0.f;
}
__device__ __forceinline__ v4u pack8(const f32x4& v0, const f32x4& v1) { v4u w; w.x = pg8::cvt_pk_bf16(v0[0], v0[1]); w.y = pg8::cvt_pk_bf16(v0[2], v0[3]); w.z = pg8::cvt_pk_bf16(v1[0], v1[1]); w.w = pg8::cvt_pk_bf16(v1[2], v1[3]); return w; }


#define XB_TMO      128
#define XB_XCNT(j)  (256  + 64 * (j))
#define XB_XSUB(j)  (1280 + 64 * (j))
#define XB_XGEN(j)  (2304 + 64 * (j))
#define XB_TOP      3328
#define XB_TOPGEN   3392
#define XCD_BAR_WORDS 3456
#define XB_SPIN_CAP (1u << 20)

__device__ __forceinline__ unsigned xb_ld(unsigned* p)              { return __hip_atomic_load(p, __ATOMIC_RELAXED, __HIP_MEMORY_SCOPE_AGENT); }
__device__ __forceinline__ unsigned xb_add(unsigned* p, unsigned v) { return __hip_atomic_fetch_add(p, v, __ATOMIC_RELAXED, __HIP_MEMORY_SCOPE_AGENT); }
__device__ __forceinline__ unsigned xb_xcc_id() { return (unsigned)__builtin_amdgcn_s_getreg((3 << 11) | 20) & 0xFu; }
#define XB_SPIN(cond, bar) do { unsigned _sp = 0; while (cond) { __builtin_amdgcn_s_sleep(1); \
    if ((++_sp & 255u) == 0u) { if (xb_ld(&(bar)[XB_TMO])) break; if (_sp > XB_SPIN_CAP) { atomicAdd(&(bar)[XB_TMO], 1u); break; } } } } while (0)

struct XcdBarrier {
    unsigned* bar; unsigned x; int tid;
    volatile LAS unsigned* st;
};

__device__ __forceinline__ XcdBarrier xcd_barrier_post(unsigned* bar, volatile LAS unsigned* st, int tid) {
    XcdBarrier b; b.bar = bar; b.x = xb_xcc_id(); b.st = st; b.tid = tid;
    if (tid == 0) (void)xb_add(&bar[XB_XCNT(b.x)], 1u);
    return b;
}
__device__ __forceinline__ void xcd_barrier_complete(unsigned* bar, unsigned x, unsigned& nloc, unsigned& nx) {
    const unsigned G = gridDim.x * gridDim.y * gridDim.z;
    unsigned sum, cnt, mine, sp = 0u;
    for (;;) {
        sum = 0u; cnt = 0u; mine = 0u;
#pragma unroll
        for (unsigned j = 0; j < 16; ++j) { const unsigned c = xb_ld(&bar[XB_XCNT(j)]); sum += c; cnt += (c > 0u) ? 1u : 0u; mine = (j == x) ? c : mine; }
        if (sum == G) break;
        __builtin_amdgcn_s_sleep(1);
        if ((++sp & 255u) == 0u) { if (xb_ld(&bar[XB_TMO])) break; if (sp > XB_SPIN_CAP) { atomicAdd(&bar[XB_TMO], 1u); break; } }
    }
    nloc = mine > 0u ? mine : 1u; nx = cnt > 0u ? cnt : 1u;
}

__device__ __forceinline__ void xcd_barrier(const XcdBarrier& b) {
    asm volatile("s_waitcnt vmcnt(0)" ::: "memory");
    __syncthreads();
    if (b.tid == 0) {
        unsigned* bar = b.bar;
        __builtin_amdgcn_s_waitcnt(0);
        unsigned nloc = b.st[0], nx = b.st[1];
        if (nloc == 0u) { xcd_barrier_complete(bar, b.x, nloc, nx); b.st[0] = nloc; b.st[1] = nx; }
        const unsigned old = xb_add(&bar[XB_XSUB(b.x)], 1u);
        const unsigned gen = old / nloc;
        if (old + 1u == (gen + 1u) * nloc) {
            __builtin_amdgcn_fence(__ATOMIC_RELEASE, "agent");
            asm volatile("s_waitcnt vmcnt(0)" ::: "memory");
            const unsigned og = xb_add(&bar[XB_TOP], 1u);
            const unsigned tg = og / nx;
            if (og + 1u == (tg + 1u) * nx) xb_add(&bar[XB_TOPGEN], 1u);
            else XB_SPIN(xb_ld(&bar[XB_TOPGEN]) == tg, bar);
            __builtin_amdgcn_fence(__ATOMIC_ACQUIRE, "agent");
            xb_add(&bar[XB_XGEN(b.x)], 1u);
            asm volatile("s_waitcnt vmcnt(0)" ::: "memory");
        } else {
            XB_SPIN(xb_ld(&bar[XB_XGEN(b.x)]) == gen, bar);
            __builtin_amdgcn_fence(__ATOMIC_ACQUIRE, "agent");
            asm volatile("s_waitcnt vmcnt(0)" ::: "memory");
        }
    }
    __syncthreads();
}


struct Args { const void* in[28]; float* out; unsigned char* ws; int ph_lo, ph_hi, li, pad; };
typedef const __attribute__((address_space(4))) Args* KArgs;
struct Frame {
    KArgs ka;
    LAS unsigned char* lds;
    int tid, lane, wave, vcu, G;
    float* out; unsigned char* ws;
    const float *x_prompt, *x_sample, *state_conv, *cache_mem, *cache_cmp, *cache_slc, *state_win, *mem_prompt;
    const int* page_table;
    unsigned long long* rs;
    float* XS; bf16 *XB, *PROJ, *Y, *ACT, *KVB, *MEMB;
    float *HID, *CK;
};
constexpr int NPH = 2 + 7 * 4 + 1;
__device__ __forceinline__ Frame mkframe(LAS unsigned char* lds, int wv) {
    Frame F;
    KArgs ka = (KArgs)__builtin_amdgcn_kernarg_segment_ptr(); asm volatile("" : "+s"(ka));
    F.ka = ka; F.lds = lds;
    F.lane = lane_id();
    F.wave = wv; F.tid = wv * 64 + F.lane;
    F.G = gridDim.x; { const int bx = blockIdx.x; F.vcu = (F.G % 8 == 0) ? (bx % 8) * (F.G / 8) + bx / 8 : bx; }
    unsigned char* ws = ka->ws;
    F.out = ka->out; F.ws = ws;
    F.x_prompt = (const float*)ka->in[0]; F.x_sample = (const float*)ka->in[1]; F.state_conv = (const float*)ka->in[2]; F.cache_mem = (const float*)ka->in[3];
    F.cache_cmp = (const float*)ka->in[4]; F.cache_slc = (const float*)ka->in[5]; F.state_win = (const float*)ka->in[6]; F.page_table = (const int*)ka->in[7]; F.mem_prompt = (const float*)ka->in[8];
    F.rs = (unsigned long long*)((float*)(ws + WS_CTL) + CW_RS);
    F.XS = (float*)(ws + WS_XS); F.XB = (bf16*)(ws + WS_XB); F.PROJ = (bf16*)(ws + WS_PROJ); F.Y = (bf16*)(ws + WS_Y); F.ACT = (bf16*)(ws + WS_ACT);
    F.KVB = (bf16*)(ws + WS_KVB); F.MEMB = (bf16*)(ws + WS_MEMB); F.HID = (float*)(ws + WS_HID); F.CK = (float*)(ws + WS_CK);
    return F;
}

__device__ __forceinline__ void tr_tile(const float* W, int N, int K, int k0, int n0, const float* gain, bf16* WT, int drow0, LAS float* scr, int lane) {
    const int kq = lane >> 3, n4 = (lane & 7) * 4; const bool ok = n0 + n4 < N;
    f32x4 v[8]; float gs[8];
#pragma unroll
    for (int i = 0; i < 8; ++i) { const int kk = kq + 8 * i; v[i] = ok ? *(const f32x4*)(W + (size_t)(k0 + kk) * N + n0 + n4) : (f32x4){0.f, 0.f, 0.f, 0.f}; gs[i] = gain ? gain[k0 + kk] : 1.f; }
    __builtin_amdgcn_sched_barrier(0);
#pragma unroll
    for (int i = 0; i < 8; ++i) { const int kk = kq + 8 * i; const f32x4 x = v[i] * gs[i];
        LAS float* s = scr + kk * 33 + n4; s[0] = x.x; s[1] = x.y; s[2] = x.z; s[3] = x.w; }
    LDS_WAIT(); asm volatile("" ::: "memory");
    const int c = lane & 7;
#pragma unroll
    for (int j = 0; j < 4; ++j) { const int n = (lane >> 3) + 8 * j; const LAS float* s = scr + (8 * c) * 33 + n;
        v4u o; o.x = pk2(s[0 * 33], s[1 * 33]); o.y = pk2(s[2 * 33], s[3 * 33]); o.z = pk2(s[4 * 33], s[5 * 33]); o.w = pk2(s[6 * 33], s[7 * 33]);
        *(v4u*)(WT + (size_t)(drow0 + n) * K + k0 + 8 * c) = o; }
    LDS_WAIT(); asm volatile("" ::: "memory");
}
__device__ __forceinline__ bool tr_mat(int& it, const float* W, int K, int N, const float* gain, bf16* WT, int mode  , int off, LAS float* scr, int lane) {
    const int nblk = (N + 31) / 32, items = (K / 64) * nblk;
    if (it >= items) { it -= items; return false; }
    const int kb = it / nblk, nb = it % nblk, n0 = nb * 32;
    int drow0 = n0 + off;
    if (mode == 1) { const int up = n0 >= FF, j = up ? n0 - FF : n0; drow0 = (j / 128) * 256 + (up ? 128 : 0) + (j % 128); }
    tr_tile(W, N, K, kb * 64, n0, gain, WT, drow0, scr, lane);
    return true;
}
__device__ __forceinline__ void prologue(Frame& F) {
    LAS float* scr = (LAS float*)(F.lds + F.wave * 16384);
    const int gw = F.vcu * NWAVES + F.wave, NGW = F.G * NWAVES, lane = F.lane;
    const float* g_mix = (const float*)F.ka->in[9]; const float* w_in_a = (const float*)F.ka->in[10]; const float* w_in_b = (const float*)F.ka->in[12]; const float* w_o = (const float*)F.ka->in[13];
    const float* w_mkv = (const float*)F.ka->in[14]; const float* g_mem = (const float*)F.ka->in[15]; const float* g_kv = (const float*)F.ka->in[16]; const float* w_kv = (const float*)F.ka->in[17];
    const float* g_ffn = (const float*)F.ka->in[24]; const float* w_gu = (const float*)F.ka->in[25]; const float* w_dn = (const float*)F.ka->in[26];
    const float* pe_[2] = {(const float*)F.ka->in[18], (const float*)F.ka->in[21]}; const float* w1_[2] = {(const float*)F.ka->in[19], (const float*)F.ka->in[22]};
    constexpr int NITEMS = 2 * 16 * 80 + 16 * 34 + 16 * 48 + 3 * 16 * 32 + 3 * 16 * 176 + 3 * 44 * 32 + 4 * 16 * 16 + 4 * 16 * 4 + 2 * 2 * 2;
    for (int item = gw; item < NITEMS; item += NGW) {
        int it = item; bool done = false;
        for (int l = 0; l < 2 && !done; ++l) done = tr_mat(it, w_in_a + (size_t)l * D * NINA, D, NINA, g_mix + l * D, (bf16*)(F.ws + WS_WINA) + (size_t)l * NINA * D, 0, 0, scr, lane);
        if (!done) done = tr_mat(it, w_in_b, D, NINB, g_mix + 2 * D, (bf16*)(F.ws + WS_WINB2), 0, 0, scr, lane);
        if (!done) done = tr_mat(it, w_kv, D, NKV, g_kv, (bf16*)(F.ws + WS_WINB2), 0, NINB_PAD, scr, lane);
        for (int l = 0; l < 3 && !done; ++l) done = tr_mat(it, w_o + (size_t)l * D * D, D, D, nullptr, (bf16*)(F.ws + WS_WO) + (size_t)l * D * D, 0, 0, scr, lane);
        for (int l = 0; l < 3 && !done; ++l) done = tr_mat(it, w_gu + (size_t)l * D * NGU, D, NGU, g_ffn + l * D, (bf16*)(F.ws + WS_WGU) + (size_t)l * NGU * D, 1, 0, scr, lane);
        for (int l = 0; l < 3 && !done; ++l) done = tr_mat(it, w_dn + (size_t)l * FF * D, FF, D, nullptr, (bf16*)(F.ws + WS_WDN) + (size_t)l * D * FF, 0, 0, scr, lane);
        for (int l = 0; l < 4 && !done; ++l) done = tr_mat(it, w_mkv + (size_t)l * D * 512, D, 512, g_mem, (bf16*)(F.ws + WS_WMKV), 0, l * 512, scr, lane);
        for (int q = 0; q < 4 && !done; ++q) done = tr_mat(it, (const float*)((q >> 1) ? F.ka->in[22] : F.ka->in[19]) + (size_t)(q & 1) * 1024 * 128, 1024, 128, nullptr, (bf16*)(F.ws + WS_WCMP), 0, q * 128, scr, lane);
        for (int q = 0; q < 2 && !done; ++q) done = tr_mat(it, (const float*)(q ? F.ka->in[23] : F.ka->in[20]), 128, 64, nullptr, (bf16*)(F.ws + WS_W2T) + (size_t)q * 64 * 128, 0, 0, scr, lane);
    }
    for (int o = gw; o < 512; o += NGW) { const int kv = o >> 8, half = (o >> 7) & 1, e = o & 127; float s = 0.f;
        for (int i = lane; i < 1024; i += 64) s += pe_[kv][half * 1024 + i] * w1_[kv][((size_t)half * 1024 + i) * 128 + e];
        s = wave_sum(s); if (lane == 0) ((float*)(F.ws + WS_CBIAS))[o] = s; }
    for (int r = gw; r < 2 * 192; r += NGW) { bf16* base = (bf16*)(F.ws + (r < 192 ? WS_WINB2 : WS_WINB3)) + (size_t)(1088 + (r % 192)) * D;
        *(v4u*)(base + lane * 16) = (v4u){0, 0, 0, 0}; *(v4u*)(base + lane * 16 + 8) = (v4u){0, 0, 0, 0}; }
    for (int r = gw; r < M + 1024; r += NGW) {
        const float* src = r < MP ? F.x_prompt + (size_t)r * D : (r < M ? F.x_sample + (size_t)(r - MP) * D : F.mem_prompt + (size_t)(r - M) * D);
        float ss = 0.f; f32x4 xv[4];
#pragma unroll
        for (int j = 0; j < 4; ++j) xv[j] = *(const f32x4*)(src + j * 256 + lane * 4);
        __builtin_amdgcn_sched_barrier(0);
#pragma unroll
        for (int j = 0; j < 4; ++j) { const f32x4 v = xv[j]; ss += v.x * v.x + v.y * v.y + v.z * v.z + v.w * v.w;
            v2u o; o.x = pk2(v.x, v.y); o.y = pk2(v.z, v.w);
            if (r < M) *(v2u*)(F.XB + (size_t)r * D + j * 256 + lane * 4) = o;
            else *(v2u*)(F.MEMB + (size_t)(r - M) * D + j * 256 + lane * 4) = o; }
        ss = wave_sum(ss);
        if (lane == 0) { if (r < M) F.rs[r] = to_fx(ss); else F.rs[9 * M + (r - M)] = to_fx(ss); }
    }
}

__device__ __forceinline__ void l3_weights_phase(Frame& F) {
    LAS float* scr = (LAS float*)(F.lds + F.wave * 16384);
    const int lane = F.lane;
    const float* g_mix = (const float*)F.ka->in[9]; const float* w_in_b = (const float*)F.ka->in[12]; const float* w_o = (const float*)F.ka->in[13];
    const float* g_ffn = (const float*)F.ka->in[24]; const float* w_gu = (const float*)F.ka->in[25]; const float* w_dn = (const float*)F.ka->in[26];
    constexpr int NIT3 = 16 * 34 + 16 * 32 + 16 * 176 + 44 * 32;
    __syncthreads();
    if ((int)blockIdx.x >= 32 && F.G > 32)
    for (int item = ((int)blockIdx.x - 32) * NWAVES + F.wave; item < NIT3; item += (F.G - 32) * NWAVES) { int it = item; bool done = false;
        done = tr_mat(it, w_in_b + (size_t)D * NINB, D, NINB, g_mix + 3 * D, (bf16*)(F.ws + WS_WINB3), 0, 0, scr, lane);
        if (!done) done = tr_mat(it, w_o + (size_t)3 * D * D, D, D, nullptr, (bf16*)(F.ws + WS_WO) + (size_t)3 * D * D, 0, 0, scr, lane);
        if (!done) done = tr_mat(it, w_gu + (size_t)3 * D * NGU, D, NGU, g_ffn + 3 * D, (bf16*)(F.ws + WS_WGU) + (size_t)3 * NGU * D, 1, 0, scr, lane);
        if (!done) done = tr_mat(it, w_dn + (size_t)3 * FF * D, FF, D, nullptr, (bf16*)(F.ws + WS_WDN) + (size_t)3 * D * FF, 0, 0, scr, lane); }
    __syncthreads();
}

__device__ __forceinline__ void win_copy_phase(Frame& F) {
    const int gw = F.vcu * NWAVES + F.wave, NGW = F.G * NWAVES, lane = F.lane;
    for (int r = gw; r < BS * 504; r += NGW) { const int b = r / 504, i = r % 504;
        const float* src = F.state_win + ((size_t)b * 512 + i + 8) * 512; float* dst = F.out + OFF_WIN_S + ((size_t)b * 512 + i) * 512;
        *(f32x4*)(dst + lane * 8) = *(const f32x4*)(src + lane * 8); *(f32x4*)(dst + lane * 8 + 4) = *(const f32x4*)(src + lane * 8 + 4); }
}

#define EPI_ROWS(u) const int row0 = (u).pm * 256 + wr * 64 + fr

struct EpiMemKV {
    static constexpr bool PERM = true, AFTER_DRAIN = false, PRE = false;
    float* out; const u64* rsm; bf16* MKB; bf16* MVT;
    __device__ __forceinline__ void operator()(const f32x4 (&acc)[2][2][4][2], const pg8::Unit& u, int wr, int wc, int fr, int fq) const {
        EPI_ROWS(u);
        float rst_[2][4];
#pragma unroll
        for (int ai = 0; ai < 2; ++ai)
#pragma unroll
            for (int m = 0; m < 4; ++m) rst_[ai][m] = from_fx(rsm[row0 + ai * 128 + m * 16]);
#pragma unroll
        for (int ai = 0; ai < 2; ++ai)
#pragma unroll
            for (int m = 0; m < 4; ++m) rst_[ai][m] = rsqrtf(rst_[ai][m] * (1.f / D) + RMS_EPS);
#pragma unroll
        for (int ai = 0; ai < 2; ++ai)
#pragma unroll
            for (int m = 0; m < 4; ++m) { const int r = row0 + ai * 128 + m * 16; const float rstd = rst_[ai][m];
#pragma unroll
                for (int bj = 0; bj < 2; ++bj) { const int c = u.pn * 256 + bj * 128 + wc * 32 + 8 * fq; const int l = c >> 9, e = c & 511;
                    float* dst = out + OFF_MEMKV + (size_t)l * (BP * NMEM * 512) + (size_t)r * 512 + e;
                    const f32x4 v0 = acc[ai][bj][m][0] * rstd, v1 = acc[ai][bj][m][1] * rstd;
                    *(f32x4*)dst = v0; *(f32x4*)(dst + 4) = v1;
                    if (e < 256) *(v4u*)(MKB + ((size_t)l * 1024 + r) * 256 + e) = pack8(v0, v1);
                    else { const int hh = (e - 256) >> 6, d0 = (e - 256) & 63, b = r >> 8, mp = vpermk(r & 255);
                        bf16* vt = MVT + ((((size_t)l * 4 + b) * 4 + hh) * 64 + d0) * 256 + mp;
#pragma unroll
                        for (int i = 0; i < 4; ++i) { vt[(size_t)i * 256] = (bf16)f2bf(v0[i]); vt[(size_t)(i + 4) * 256] = (bf16)f2bf(v1[i]); } } } }
    }
};
struct EpiInA {
    static constexpr bool PERM = true, AFTER_DRAIN = false, PRE = true;
    bf16* O; int ld; const u64* rsq;
    __device__ __forceinline__ void pre(const pg8::Unit& u, int wr, int fr, u64 (&q)[8]) const { EPI_ROWS(u);
#pragma unroll
        for (int i = 0; i < 8; ++i) q[i] = rsq[row0 + (i >> 2) * 128 + (i & 3) * 16]; }
    __device__ __forceinline__ void operator()(const f32x4 (&acc)[2][2][4][2], const pg8::Unit& u, int wr, int wc, int fr, int fq, const u64 (&q)[8]) const {
        EPI_ROWS(u); const int col0 = u.pn * 256 + wc * 32 + 8 * fq;
        float rst_[2][4];
#pragma unroll
        for (int ai = 0; ai < 2; ++ai)
#pragma unroll
            for (int m = 0; m < 4; ++m) rst_[ai][m] = from_fx(q[ai * 4 + m]);
#pragma unroll
        for (int ai = 0; ai < 2; ++ai)
#pragma unroll
            for (int m = 0; m < 4; ++m) rst_[ai][m] = rsqrtf(rst_[ai][m] * (1.f / D) + RMS_EPS);
#pragma unroll
        for (int ai = 0; ai < 2; ++ai)
#pragma unroll
            for (int m = 0; m < 4; ++m) { const int r = row0 + ai * 128 + m * 16; const float rstd = rst_[ai][m];
#pragma unroll
                for (int bj = 0; bj < 2; ++bj) *(v4u*)(O + (size_t)r * ld + col0 + bj * 128) = pack8(acc[ai][bj][m][0] * rstd, acc[ai][bj][m][1] * rstd); }
    }
};
struct EpiInB {
    static constexpr bool PERM = true, AFTER_DRAIN = false, PRE = true;
    bf16* O; bf16* KVB; float* out; const u64* rsq; bf16* VTB; bf16* CMPA; bf16* KTB;
    __device__ __forceinline__ void pre(const pg8::Unit& u, int wr, int fr, u64 (&q)[8]) const { EPI_ROWS(u);
#pragma unroll
        for (int i = 0; i < 8; ++i) q[i] = rsq[row0 + (i >> 2) * 128 + (i & 3) * 16]; }
    __device__ __forceinline__ void operator()(const f32x4 (&acc)[2][2][4][2], const pg8::Unit& u, int wr, int wc, int fr, int fq, const u64 (&q)[8]) const {
        EPI_ROWS(u);
        float rst_[2][4];
#pragma unroll
        for (int ai = 0; ai < 2; ++ai)
#pragma unroll
            for (int m = 0; m < 4; ++m) rst_[ai][m] = from_fx(q[ai * 4 + m]);
#pragma unroll
        for (int ai = 0; ai < 2; ++ai)
#pragma unroll
            for (int m = 0; m < 4; ++m) rst_[ai][m] = rsqrtf(rst_[ai][m] * (1.f / D) + RMS_EPS);
        if (u.pn < 5) {
            const int col0 = u.pn * 256 + wc * 32 + 8 * fq;
#pragma unroll
            for (int ai = 0; ai < 2; ++ai)
#pragma unroll
                for (int m = 0; m < 4; ++m) { const int r = row0 + ai * 128 + m * 16; const float rstd = rst_[ai][m];
#pragma unroll
                    for (int bj = 0; bj < 2; ++bj) *(v4u*)(O + (size_t)r * NINB_PAD + col0 + bj * 128) = pack8(acc[ai][bj][m][0] * rstd, acc[ai][bj][m][1] * rstd); }
        } else {
            const int kc = (u.pn - 5) * 256, br = kc >> 9, w0 = (kc & 511) + wc * 32 + 8 * fq;
#pragma unroll
            for (int ai = 0; ai < 2; ++ai)
#pragma unroll
                for (int m = 0; m < 4; ++m) { const int r = row0 + ai * 128 + m * 16; const float rstd = rst_[ai][m];
                    float* dst = nullptr;
                    if (r < MP) { const int b = r >> 12, t = r & 4095;
                        if (br == 0) dst = out + OFF_CMP_P + (size_t)r * 512; else if (br == 1) dst = out + OFF_SLC_P + (size_t)r * 512;
                        else if (t >= TP - 512) dst = out + OFF_WIN_P + ((size_t)b * 512 + (t - (TP - 512))) * 512; }
                    else { const int rs_ = r - MP, b = rs_ >> 3, t = rs_ & 7;
                        if (br == 0) dst = out + OFF_CMP_S + (size_t)rs_ * 512; else if (br == 1) dst = out + OFF_SLC_S + (size_t)rs_ * 512;
                        else dst = out + OFF_WIN_S + ((size_t)b * 512 + 504 + t) * 512; }
#pragma unroll
                    for (int bj = 0; bj < 2; ++bj) { const f32x4 v0 = acc[ai][bj][m][0] * rstd, v1 = acc[ai][bj][m][1] * rstd;
                        if (dst) { *(f32x4*)(dst + w0 + bj * 128) = v0; *(f32x4*)(dst + w0 + bj * 128 + 4) = v1; }
                        const int wi = w0 + bj * 128;
                        if (br == 0 && r < MP) { const int kv = wi >> 8, kvh = (wi >> 6) & 3, d0 = wi & 63, b = r >> 12, t_ = r & 4095;
                            *(v4u*)(CMPA + ((size_t)kv * NR + ((size_t)b * CHP + (t_ >> 4)) * 4 + kvh) * 1024 + (t_ & 15) * 64 + d0) = pack8(v0, v1); }
                        if (br >= 1 && r < MP) { const int kvh = (wi >> 6) & 3, d0 = wi & 63, b = r >> 12, t_ = r & 4095;
                            if (wi < 256) *(v4u*)(KTB + (((((size_t)(br - 1) * 4 + b) * 4 + kvh) << 12) + t_) * 64 + d0) = pack8(v0, v1);
                            else { bf16* vt = VTB + ((((((size_t)(br - 1) * 4 + b) * 4 + kvh) * 64 + (t_ >> 6)) * 64 + d0) << 6) + vpermk(t_ & 63);
#pragma unroll
                                for (int i = 0; i < 4; ++i) { vt[i << 6] = (bf16)f2bf(v0[i]); vt[(i + 4) << 6] = (bf16)f2bf(v1[i]); } } } } }
        }
    }
};
struct EpiRes {
    static constexpr bool PERM = true, AFTER_DRAIN = false, PRE = false;
    bf16* XB; u64* rsn;
    __device__ __forceinline__ void operator()(const f32x4 (&acc)[2][2][4][2], const pg8::Unit& u, int wr, int wc, int fr, int fq) const {
        EPI_ROWS(u); const int col0 = u.pn * 256 + wc * 32 + 8 * fq;
        v4u xv[2][4][2];
#pragma unroll
        for (int ai = 0; ai < 2; ++ai)
#pragma unroll
            for (int m = 0; m < 4; ++m)
#pragma unroll
                for (int bj = 0; bj < 2; ++bj) xv[ai][m][bj] = *(const v4u*)(XB + (size_t)(row0 + ai * 128 + m * 16) * D + col0 + bj * 128);
        __builtin_amdgcn_sched_barrier(0);
#pragma unroll
        for (int ai = 0; ai < 2; ++ai) {
#pragma unroll
            for (int m = 0; m < 4; ++m) { const int r = row0 + ai * 128 + m * 16; float ss = 0.f;
#pragma unroll
                for (int bj = 0; bj < 2; ++bj) { const v4u x = xv[ai][m][bj];
                    const f32x4 v0 = (f32x4){bflo(x.x), bfhi(x.x), bflo(x.y), bfhi(x.y)} + acc[ai][bj][m][0], v1 = (f32x4){bflo(x.z), bfhi(x.z), bflo(x.w), bfhi(x.w)} + acc[ai][bj][m][1];
                    *(v4u*)(XB + (size_t)r * D + col0 + bj * 128) = pack8(v0, v1);
                    ss += v0.x * v0.x + v0.y * v0.y + v0.z * v0.z + v0.w * v0.w + v1.x * v1.x + v1.y * v1.y + v1.z * v1.z + v1.w * v1.w; }
                ss += __shfl_xor(ss, 16); ss += __shfl_xor(ss, 32);
                if (fq == 0) atomicAdd(rsn + r, to_fx(ss)); }
        }
    }
};
constexpr int CW_FIN = 8192;
static_assert(CW_FIN + 64 * 80 <= CW_RS && CW_FIN >= CW_BAR + 3456, "final counters inside the control region");
__device__ __forceinline__ void fin_wait(unsigned* cnt, const unsigned need) {
    if (lane_id() == 0) { unsigned sp = 0; while (__hip_atomic_load(cnt, __ATOMIC_RELAXED, __HIP_MEMORY_SCOPE_AGENT) < need && ++sp < (1u << 22)) __builtin_amdgcn_s_sleep(1); }
    asm volatile("" ::: "memory");
}
struct EpiFinal {
    static constexpr bool PERM = true, AFTER_DRAIN = false, PRE = false;
    const bf16* XB; u64* rsn; float* out; const float* g; unsigned* cnt;
    __device__ __forceinline__ void operator()(const f32x4 (&acc)[2][2][4][2], const pg8::Unit& u, int wr, int wc, int fr, int fq) const {
        EPI_ROWS(u); const int col0 = u.pn * 256 + wc * 32 + 8 * fq;
        v4u xv[2][4][2];
#pragma unroll
        for (int ai = 0; ai < 2; ++ai)
#pragma unroll
            for (int m = 0; m < 4; ++m)
#pragma unroll
                for (int bj = 0; bj < 2; ++bj) xv[ai][m][bj] = *(const v4u*)(XB + (size_t)(row0 + ai * 128 + m * 16) * D + col0 + bj * 128);
        f32x4 gg[2][2];
#pragma unroll
        for (int bj = 0; bj < 2; ++bj) { gg[bj][0] = *(const f32x4*)(g + col0 + bj * 128); gg[bj][1] = *(const f32x4*)(g + col0 + bj * 128 + 4); }
        __builtin_amdgcn_sched_barrier(0);
        f32x4 x[2][4][2][2];
#pragma unroll
        for (int ai = 0; ai < 2; ++ai)
#pragma unroll
            for (int m = 0; m < 4; ++m) { const int r = row0 + ai * 128 + m * 16; float ss = 0.f;
#pragma unroll
                for (int bj = 0; bj < 2; ++bj) { const v4u o_ = xv[ai][m][bj];
                    const f32x4 v0 = (f32x4){bflo(o_.x), bfhi(o_.x), bflo(o_.y), bfhi(o_.y)} + acc[ai][bj][m][0], v1 = (f32x4){bflo(o_.z), bfhi(o_.z), bflo(o_.w), bfhi(o_.w)} + acc[ai][bj][m][1];
                    x[ai][m][bj][0] = v0; x[ai][m][bj][1] = v1;
                    ss += v0.x * v0.x + v0.y * v0.y + v0.z * v0.z + v0.w * v0.w + v1.x * v1.x + v1.y * v1.y + v1.z * v1.z + v1.w * v1.w; }
                ss += __shfl_xor(ss, 16); ss += __shfl_xor(ss, 32);
                if (fq == 0) atomicAdd(rsn + r, to_fx(ss)); }
        asm volatile("s_waitcnt vmcnt(0)" ::: "memory");
        unsigned* c_ = cnt + 64 * u.pm;
        if (lane_id() == 0) __hip_atomic_fetch_add(c_, 1u, __ATOMIC_RELAXED, __HIP_MEMORY_SCOPE_AGENT);
        fin_wait(c_, 32u);
        float rst_[2][4];
#pragma unroll
        for (int ai = 0; ai < 2; ++ai)
#pragma unroll
            for (int m = 0; m < 4; ++m) rst_[ai][m] = from_fx(__hip_atomic_load(rsn + row0 + ai * 128 + m * 16, __ATOMIC_RELAXED, __HIP_MEMORY_SCOPE_AGENT));
#pragma unroll
        for (int ai = 0; ai < 2; ++ai)
#pragma unroll
            for (int m = 0; m < 4; ++m) { const int r = row0 + ai * 128 + m * 16; const float rstd = rsqrtf(rst_[ai][m] * (1.f / D) + RMS_EPS);
                float* dst = out + OFF_YP + (size_t)r * D + col0;
#pragma unroll
                for (int bj = 0; bj < 2; ++bj) { *(f32x4*)(dst + bj * 128) = x[ai][m][bj][0] * rstd * gg[bj][0]; *(f32x4*)(dst + bj * 128 + 4) = x[ai][m][bj][1] * rstd * gg[bj][1]; } }
    }
};
struct EpiNull {
    static constexpr bool PERM = true, AFTER_DRAIN = false, PRE = false;
    __device__ __forceinline__ void operator()(const f32x4 (&acc)[2][2][4][2], const pg8::Unit& u, int wr, int wc, int fr, int fq) const { if (acc[0][0][0][0][0] == 1.2345e-33f) *(volatile int*)nullptr = 0; }
};
struct EpiGU {
    static constexpr bool PERM = true, AFTER_DRAIN = false, PRE = true;
    bf16* O; const u64* rsq;
    __device__ __forceinline__ void pre(const pg8::Unit& u, int wr, int fr, u64 (&q)[8]) const { EPI_ROWS(u);
#pragma unroll
        for (int i = 0; i < 8; ++i) q[i] = rsq[row0 + (i >> 2) * 128 + (i & 3) * 16]; }
    __device__ __forceinline__ void operator()(const f32x4 (&acc)[2][2][4][2], const pg8::Unit& u, int wr, int wc, int fr, int fq, const u64 (&q)[8]) const {
        EPI_ROWS(u); const int col0 = u.pn * 128 + wc * 32 + 8 * fq;
        float rst_[2][4];
#pragma unroll
        for (int ai = 0; ai < 2; ++ai)
#pragma unroll
            for (int m = 0; m < 4; ++m) rst_[ai][m] = from_fx(q[ai * 4 + m]);
#pragma unroll
        for (int ai = 0; ai < 2; ++ai)
#pragma unroll
            for (int m = 0; m < 4; ++m) rst_[ai][m] = rst_[ai][m] * (1.f / D) + RMS_EPS;
#pragma unroll
        for (int ai = 0; ai < 2; ++ai)
#pragma unroll
            for (int m = 0; m < 4; ++m) { const int r = row0 + ai * 128 + m * 16; const float iv = rst_[ai][m], c1 = rsqrtf(iv) * -1.4426950408889634f;
                f32x4 o[2];
#pragma unroll
                for (int n = 0; n < 2; ++n)
#pragma unroll
                    for (int c = 0; c < 4; c += 2) {
                        const f32x2_t g = {acc[ai][0][m][n][c], acc[ai][0][m][n][c + 1]}, up = {acc[ai][1][m][n][c], acc[ai][1][m][n][c + 1]};
                        const f32x2_t t = g * c1; const f32x2_t e = {__builtin_amdgcn_exp2f(t.x), __builtin_amdgcn_exp2f(t.y)};
                        const f32x2_t d = e * iv + iv; const f32x2_t rr = {__builtin_amdgcn_rcpf(d.x), __builtin_amdgcn_rcpf(d.y)};
                        const f32x2_t q = (g * up) * rr; o[n][c] = q.x; o[n][c + 1] = q.y; }
                *(v4u*)(O + (size_t)r * FF + col0) = pack8(o[0], o[1]); }
    }
};

struct CmpOrder {
    int p0, np, G, c;
    __device__ __forceinline__ bool next(int i, pg8::Unit& u) const { const long L = (long)i * G + c; if (L >= 2 * np) return false; const int kv = L >= np ? 1 : 0; u.pm = kv * (int)(NR / 256) + p0 + ((int)L - kv * np); u.pn = kv; return true; }
    __device__ __forceinline__ void a_ready(const pg8::Unit&) const {}
    __device__ __forceinline__ void done(const pg8::Unit&) const {}
};
struct EpiHid {
    static constexpr bool PERM = true, AFTER_DRAIN = false, PRE = false;
    bf16* O; const float* bias;
    __device__ __forceinline__ void operator()(const f32x4 (&acc)[2][2][4][2], const pg8::Unit& u, int wr, int wc, int fr, int fq) const {
        EPI_ROWS(u); const int col0 = wc * 32 + 8 * fq;
        f32x4 bv[2][2];
#pragma unroll
        for (int bj = 0; bj < 2; ++bj)
#pragma unroll
            for (int n = 0; n < 2; ++n) bv[bj][n] = *(const f32x4*)(bias + u.pn * 256 + bj * 128 + col0 + 4 * n);
#pragma unroll
        for (int ai = 0; ai < 2; ++ai)
#pragma unroll
            for (int m = 0; m < 4; ++m) { const int r = row0 + ai * 128 + m * 16;
#pragma unroll
                for (int bj = 0; bj < 2; ++bj) *(v4u*)(O + (size_t)r * 256 + col0 + bj * 128) = pack8(acc[ai][bj][m][0] + bv[bj][0], acc[ai][bj][m][1] + bv[bj][1]); }
    }
};


template <bool FINAL = false> __device__ __forceinline__ void sample_res_gemm(Frame& F, const bf16* A, int K, const bf16* Bt, u64* rsn, const float* g_final = nullptr) {
    const int lane = F.lane, w = F.wave, tid = F.tid, rw = lane & 15, quad = lane >> 4, kw = K >> 3, k0 = w * kw;
    LAS f32x4* red = (LAS f32x4*)F.lds; LAS u64* rsL = (LAS u64*)(F.lds + 32768);
    for (int unit = F.vcu; unit < 256; unit += F.G) {
        const int r0 = MP + 16 * (unit >> 4), n0 = 64 * (unit & 15);
        f32x4 acc[4];
#pragma unroll
        for (int nb = 0; nb < 4; ++nb) acc[nb] = (f32x4){0.f, 0.f, 0.f, 0.f};
        const bf16* ap = A + (size_t)(r0 + rw) * K + k0 + quad * 8; const bf16* bp = Bt + (size_t)(n0 + rw) * K + k0 + quad * 8;
        bf16 xo[4];
        { const int nbx = (tid >> 6) & 3, lnx = tid & 63;
#pragma unroll
          for (int j = 0; j < 4; ++j) xo[j] = ((const bf16*)(F.ws + WS_XB))[(size_t)(r0 + (lnx >> 4) * 4 + j) * D + n0 + 16 * nbx + (lnx & 15)]; }
        bf16x8 a[2][4], bq[2][4][4];
#define SRG_LOAD(buf, kk) do { _Pragma("unroll") for (int s = 0; s < 4; ++s) if ((kk) + 32 * s < kw) { a[buf][s] = *(const bf16x8*)(ap + (kk) + 32 * s); \
            _Pragma("unroll") for (int nb = 0; nb < 4; ++nb) bq[buf][s][nb] = *(const bf16x8*)(bp + (size_t)nb * 16 * K + (kk) + 32 * s); } } while (0)
#define SRG_MMA(buf, kk) do { _Pragma("unroll") for (int s = 0; s < 4; ++s) if ((kk) + 32 * s < kw) { \
            _Pragma("unroll") for (int nb = 0; nb < 4; ++nb) acc[nb] = __builtin_amdgcn_mfma_f32_16x16x32_bf16(a[buf][s], bq[buf][s][nb], acc[nb], 0, 0, 0); } } while (0)
        SRG_LOAD(0, 0);
        if (128 < kw) SRG_LOAD(1, 128);
        __builtin_amdgcn_sched_barrier(0);
        SRG_MMA(0, 0);
        if (256 < kw) SRG_LOAD(0, 256);
        __builtin_amdgcn_sched_barrier(0);
        if (128 < kw) SRG_MMA(1, 128);
        if (256 < kw) SRG_MMA(0, 256);
#undef SRG_LOAD
#undef SRG_MMA
        __syncthreads();
#pragma unroll
        for (int nb = 0; nb < 4; ++nb) red[(w * 4 + nb) * 64 + lane] = acc[nb];
        if (tid < 16) rsL[tid] = 0ull;
        __syncthreads();
        if (tid < 256) { const int nb = tid >> 6, ln = tid & 63; f32x4 s = red[nb * 64 + ln];
#pragma unroll
            for (int ww = 1; ww < 8; ++ww) s += red[(ww * 4 + nb) * 64 + ln];
#pragma unroll
            for (int j = 0; j < 4; ++j) { const int rl = (ln >> 4) * 4 + j; const size_t idx = (size_t)(r0 + rl) * D + n0 + 16 * nb + (ln & 15);
                const float x = bf2f(xo[j]) + s[j]; if (!FINAL) ((bf16*)(F.ws + WS_XB))[idx] = (bf16)f2bf(x); else s[j] = x;
                atomicAdd((u64*)(rsL + rl), to_fx(x * x)); }
            if (FINAL) red[tid] = s; }
        __syncthreads();
        if (tid < 16) atomicAdd(rsn + r0 + tid, (u64)rsL[tid]);
        if (FINAL) {
            LAS float* rstL = (LAS float*)(F.lds + 32768 + 256);
            if (w == 0) { asm volatile("s_waitcnt vmcnt(0)" ::: "memory");
                unsigned* c_ = (unsigned*)(F.ws + WS_CTL) + CW_FIN + 64 * (64 + (unit >> 4));
                if (lane_id() == 0) __hip_atomic_fetch_add(c_, 1u, __ATOMIC_RELAXED, __HIP_MEMORY_SCOPE_AGENT);
                fin_wait(c_, 16u);
                if (tid < 16) rstL[tid] = rsqrtf(from_fx(__hip_atomic_load(rsn + r0 + tid, __ATOMIC_RELAXED, __HIP_MEMORY_SCOPE_AGENT)) * (1.f / D) + RMS_EPS); }
            __syncthreads();
            if (tid < 256) { const int nb = tid >> 6, ln = tid & 63; const f32x4 xs = red[tid];
#pragma unroll
                for (int j = 0; j < 4; ++j) { const int rl = (ln >> 4) * 4 + j, col = n0 + 16 * nb + (ln & 15);
                    F.out[OFF_YS + (size_t)(r0 - MP + rl) * D + col] = xs[j] * rstL[rl] * g_final[col]; } } }
    }
    __syncthreads();
}

__device__ __forceinline__ void cmp_sample_fused_phase(Frame& F) {
    constexpr int BPI = 136;
    LAS bf16* Bs = (LAS bf16*)F.lds;
    const int w = F.wave;
    const bf16* WC = (const bf16*)(F.ws + WS_WCMP); const float* bias = (const float*)(F.ws + WS_CBIAS); bf16* HB = (bf16*)(F.ws + WS_HIDB);
    for (int unit = F.vcu; unit < 2 * BS * 8; unit += F.G) {
        const int lane = lane_id(), tid = w * 64 + lane, rw = lane & 15, quad = lane >> 4, kvh = rw & 3;
        const int kv = unit >> 8, b = (unit >> 3) & 31, cg = unit & 7, chunk0 = cg * 64 + 8 * w + (rw >> 2);
        const bf16* wsrc = WC + (size_t)(kv * 256) * 1024;
        f32x4 areg[2][4][2];
        const int pgw = __builtin_amdgcn_readfirstlane(F.page_table[b * NPAGES + cg * 8 + w]);
        const char* ubase = (const char*)(F.cache_cmp + ((size_t)pgw * 128) * 512 + kv * 256);
        unsigned loff = (unsigned)((((rw >> 2) * 16) * 512 + kvh * 64 + quad * 8) * 4); asm volatile("" : "+v"(loff));
#define CSF_FETCH1(kc, t, s) do { const char* p_ = ubase + (size_t)(((64 * (t) + 2 * (kc) + ((s) >> 1)) * 512 + ((s) & 1) * 32) * 4); \
            areg[t][s][0] = __builtin_nontemporal_load((const f32x4*)(p_ + loff)); areg[t][s][1] = __builtin_nontemporal_load((const f32x4*)(p_ + loff + 16)); } while (0)
        f32x4 acc[2][16];
#pragma unroll
        for (int nb = 0; nb < 16; ++nb) acc[0][nb] = *(const f32x4*)(bias + kv * 256 + nb * 16 + quad * 4);
        v4u breg[8];
#define CSF_BT(kc) do { unsigned tq = (unsigned)tid; asm volatile("" : "+v"(tq)); const char* wk = (const char*)(wsrc + (kc) * 128); \
            _Pragma("unroll") for (int it = 0; it < 8; ++it) { const unsigned i = tq + 512u * it; breg[it] = *(const v4u*)(wk + ((i >> 4) * 2048u + (i & 15u) * 16u)); } } while (0)
        CSF_BT(0);
#pragma unroll
        for (int t = 0; t < 2; ++t)
#pragma unroll
            for (int s = 0; s < 4; ++s) CSF_FETCH1(0, t, s);
        __builtin_amdgcn_sched_barrier(0);
#pragma unroll
        for (int nb = 0; nb < 16; ++nb) acc[1][nb] = acc[0][nb];
        for (int kc = 0; kc < 8; ++kc) {
            __syncthreads();
            { unsigned tq = (unsigned)tid; asm volatile("" : "+v"(tq));
#pragma unroll
              for (int it = 0; it < 8; ++it) { const unsigned i = tq + 512u * it; *(LAS v4u*)(Bs + (i >> 4) * BPI + (i & 15u) * 8u) = breg[it]; } }
            __syncthreads();
            if (kc < 7) CSF_BT(kc + 1);
            __builtin_amdgcn_sched_barrier(0);
#pragma unroll
            for (int s = 0; s < 4; ++s) {
                const bf16x8 a0 = __builtin_bit_cast(bf16x8, pack8(areg[0][s][0], areg[0][s][1])), a1 = __builtin_bit_cast(bf16x8, pack8(areg[1][s][0], areg[1][s][1]));
                if (kc < 7) { CSF_FETCH1(kc + 1, 0, s); CSF_FETCH1(kc + 1, 1, s); }
#pragma unroll
                for (int nb = 0; nb < 16; ++nb) { const bf16x8 bq = *(const LAS bf16x8*)(Bs + (nb * 16 + rw) * BPI + s * 32 + quad * 8);
                    acc[0][nb] = __builtin_amdgcn_mfma_f32_16x16x32_bf16(bq, a0, acc[0][nb], 0, 0, 0); acc[1][nb] = __builtin_amdgcn_mfma_f32_16x16x32_bf16(bq, a1, acc[1][nb], 0, 0, 0); }
                __builtin_amdgcn_sched_barrier(0); }
        }
#undef CSF_BT
        __builtin_amdgcn_sched_barrier(0);
#undef CSF_FETCH1
        { const int ln = lane_id(), rw2 = ln & 15, quad2 = ln >> 4;
#pragma unroll
          for (int t = 0; t < 2; ++t) { const size_t row = (size_t)kv * NR + ((size_t)BP * CHP + (size_t)b * CHS + cg * 64 + 8 * w + (rw2 >> 2) + 4 * t) * 4 + (rw2 & 3);
#pragma unroll
            for (int nb = 0; nb < 16; ++nb) { const f32x4 v = acc[t][nb];
                v2u o; o.x = cvtpk(v.x, v.y); o.y = cvtpk(v.z, v.w); *(v2u*)(HB + row * 256 + nb * 16 + quad2 * 4) = o; } } }
    }
    __syncthreads();
}

__device__ __forceinline__ void conv_phase(Frame& F, int l, const float* conv_w) {
    const int gw = F.vcu * NWAVES + F.wave, NGW = F.G * NWAVES, lane = F.lane;
    const float* cw = conv_w + (size_t)l * 3 * CONV;
    f32x4 w[3][3];
#pragma unroll
    for (int i = 0; i < 3; ++i)
#pragma unroll
        for (int kk = 0; kk < 3; ++kk) w[i][kk] = *(const f32x4*)(cw + kk * CONV + 256 * i + 4 * lane);
    for (int pass = 0; pass < 2; ++pass)
    for (int v = pass == 0 ? gw : NGW - 1 - gw; v < (pass == 0 ? MP / 8 : MS); v += NGW) {
        if (pass == 1 && (v & 7)) continue;
        const int seg = pass == 0 ? v : MP / 8 + (v >> 3);
        const int r0 = seg * 8; const bool S = r0 >= MP; const int b = S ? (r0 - MP) >> 3 : r0 >> 12, t0 = S ? 0 : r0 & 4095, T = S ? TS : TP;
        float* cs = S ? F.out + OFF_CSS + ((size_t)l * BS + b) * 2 * CONV : F.out + OFF_CSP + ((size_t)l * BP + b) * 2 * CONV;
        f32x4 u1[3], u2[3];
        v2u in_[8][3][3];
#pragma unroll
        for (int j = 0; j < 8; ++j) { const bf16* pr = F.PROJ + (size_t)(r0 + j) * NINA;
#pragma unroll
            for (int i = 0; i < 3; ++i) { const int c0 = 256 * i + 4 * lane; in_[j][i][0] = *(const v2u*)(pr + c0); in_[j][i][1] = *(const v2u*)(pr + CONV + c0); in_[j][i][2] = *(const v2u*)(pr + 2 * CONV + c0); } }
#pragma unroll
        for (int i = 0; i < 3; ++i) { const int c0 = 256 * i + 4 * lane;
            if (S) { const float* st = F.state_conv + ((size_t)l * BS + b) * 2 * CONV; u2[i] = *(const f32x4*)(st + c0); u1[i] = *(const f32x4*)(st + CONV + c0); }
            else if (t0 == 0) { u1[i] = (f32x4){0.f, 0.f, 0.f, 0.f}; u2[i] = u1[i]; }
            else {
#pragma unroll
                for (int kk = 0; kk < 2; ++kk) { const bf16* pr = F.PROJ + (size_t)(r0 - 2 + kk) * NINA; const v2u cg = *(const v2u*)(pr + CONV + c0), hh = *(const v2u*)(pr + 2 * CONV + c0);
                    const f32x4 uu = {bflo(cg.x) * bflo(hh.x), bfhi(cg.x) * bfhi(hh.x), bflo(cg.y) * bflo(hh.y), bfhi(cg.y) * bfhi(hh.y)};
                    if (kk == 0) u2[i] = uu; else u1[i] = uu; } } }
        __builtin_amdgcn_sched_barrier(0);
#pragma unroll
        for (int j = 0; j < 8; ++j) { const int r = r0 + j, t = t0 + j;
#pragma unroll
            for (int i = 0; i < 3; ++i) { const int c0 = 256 * i + 4 * lane;
                const v2u bg = in_[j][i][0], cg = in_[j][i][1], hh = in_[j][i][2];
                const f32x4 uu = {bflo(cg.x) * bflo(hh.x), bfhi(cg.x) * bfhi(hh.x), bflo(cg.y) * bflo(hh.y), bfhi(cg.y) * bfhi(hh.y)};
                const f32x4 y = w[i][0] * u2[i] + w[i][1] * u1[i] + w[i][2] * uu;
                if (t >= T - 2) *(f32x4*)(cs + (size_t)(t - (T - 2)) * CONV + c0) = uu;
                v2u o; o.x = pk2(bflo(bg.x) * y.x, bfhi(bg.x) * y.y); o.y = pk2(bflo(bg.y) * y.z, bfhi(bg.y) * y.w);
                *(v2u*)(F.Y + (size_t)r * D + c0) = o;
                u2[i] = u1[i]; u1[i] = uu; } }
    }
}
__device__ __forceinline__ void memattn_phase(Frame& F, int l, int ldp, int qoff) {
    LAS float* Ks = (LAS float*)F.lds; LAS float* Vs = Ks + 256 * 65; LAS float* ps = Vs + 256 * 64 + F.wave * 256; LAS float* qs = Vs + 256 * 64 + 8 * 256 + F.wave * 64;
    const int lane = F.lane;
    constexpr int NU = BP * 4 * 16 + BS * 4;
    for (int u = F.vcu; u < NU; u += F.G) {
        int row0, nrows, h; const float* kv;
        if (u < BP * 4 * 16) { const int b = u >> 6, ch = u & 15; h = (u >> 4) & 3; row0 = b * TP + ch * 256; nrows = 256; kv = F.out + OFF_MEMKV + ((size_t)l * BP + b) * NMEM * 512; }
        else { const int v = u - BP * 4 * 16, b = v >> 2; h = v & 3; row0 = MP + b * TS; nrows = TS; kv = F.cache_mem + ((size_t)l * BS + b) * NMEM * 512; }
        __syncthreads();
        for (int i = F.tid; i < 256 * 16; i += 512) { const int m = i >> 4, d4 = (i & 15) * 4;
            const f32x4 k = *(const f32x4*)(kv + (size_t)m * 512 + h * 64 + d4), v = *(const f32x4*)(kv + (size_t)m * 512 + 256 + h * 64 + d4);
            Ks[m * 65 + d4] = k.x; Ks[m * 65 + d4 + 1] = k.y; Ks[m * 65 + d4 + 2] = k.z; Ks[m * 65 + d4 + 3] = k.w; *(LAS f32x4*)(Vs + m * 64 + d4) = v; }
        __syncthreads();
        for (int rr = F.wave; rr < nrows; rr += NWAVES) { const int r = row0 + rr;
            qs[lane] = bf2f(F.PROJ[(size_t)r * ldp + qoff + h * 64 + lane]) * 0.125f;
            LDS_WAIT();
            float s[4] = {0.f, 0.f, 0.f, 0.f};
            for (int d = 0; d < 64; ++d) { const float q = qs[d];
#pragma unroll
                for (int j = 0; j < 4; ++j) s[j] += q * Ks[(lane + 64 * j) * 65 + d]; }
            const float mx = wave_max(fmaxf(fmaxf(s[0], s[1]), fmaxf(s[2], s[3])));
            float p[4], sum = 0.f;
#pragma unroll
            for (int j = 0; j < 4; ++j) { p[j] = __expf(s[j] - mx); sum += p[j]; }
            const float inv = 1.f / wave_sum(sum);
#pragma unroll
            for (int j = 0; j < 4; ++j) ps[lane + 64 * j] = p[j] * inv;
            LDS_WAIT();
            float o = 0.f;
            for (int m = 0; m < 256; ++m) o += ps[m] * Vs[m * 64 + lane];
            F.Y[(size_t)r * D + CONV + h * 64 + lane] = (bf16)f2bf(o);
            LDS_WAIT(); }
    }
    __syncthreads();
}

__device__ __forceinline__ void ctx1_phase(Frame& F) {
    LAS float* rs = (LAS float*)F.lds;
    LAS float* pes = rs + 16384;
    const float* pe[2] = {(const float*)F.ka->in[18], (const float*)F.ka->in[21]}; const float* w1[2] = {(const float*)F.ka->in[19], (const float*)F.ka->in[22]};
    const int tid = F.tid, kvs = tid >> 8, o = tid & 255, half = o >> 7, e = o & 127;
    for (int i = tid; i < 4096; i += 512) pes[i] = pe[i >> 11][i & 2047];
    constexpr int NT = (BP * 32 + BS * 64) * 4;
    for (int task = F.vcu; task < NT; task += F.G) {
        const int kvh = task & 3, g = task >> 2; const bool S = g >= BP * 32; const int b = S ? (g - BP * 32) >> 6 : g >> 5, cg = S ? (g - BP * 32) & 63 : g & 31;
        __syncthreads();
        for (int i = tid; i < 2 * 8 * 16 * 16; i += 512) { const int d4 = (i & 15) * 4, j = (i >> 4) & 15, c = (i >> 8) & 7, kv = i >> 11; const int pos = (cg * 8 + c) * 16 + j;
            f32x4 v;
            if (!S) { const v2u w = *(const v2u*)(F.KVB + ((size_t)b * TP + pos) * NKV + kv * 256 + kvh * 64 + d4); v = (f32x4){bflo(w.x), bfhi(w.x), bflo(w.y), bfhi(w.y)}; }
            else { const int pg = F.page_table[b * NPAGES + (pos >> 7)]; v = *(const f32x4*)(F.cache_cmp + ((size_t)pg * 128 + (pos & 127)) * 512 + kv * 256 + kvh * 64 + d4); }
            *(LAS f32x4*)(rs + ((kv * 8 + c) * 16 + j) * 64 + d4) = v; }
        __syncthreads();
        float acc[8] = {0.f, 0.f, 0.f, 0.f, 0.f, 0.f, 0.f, 0.f}; float accb = 0.f;
        const float* w = w1[kvs] + (size_t)(half * 16) * 64 * 128 + e;
#pragma unroll 1
        for (int j = 0; j < 16; ++j)
#pragma unroll 2
            for (int d4 = 0; d4 < 64; d4 += 4) {
                const float w0 = w[(size_t)(j * 64 + d4) * 128], w1_ = w[(size_t)(j * 64 + d4 + 1) * 128], w2 = w[(size_t)(j * 64 + d4 + 2) * 128], w3 = w[(size_t)(j * 64 + d4 + 3) * 128];
                const f32x4 p4 = *(const LAS f32x4*)(pes + (kvs * 32 + half * 16 + j) * 64 + d4);
                accb += p4.x * w0 + p4.y * w1_ + p4.z * w2 + p4.w * w3;
#pragma unroll
                for (int c = 0; c < 8; ++c) { const f32x4 r4 = *(const LAS f32x4*)(rs + ((kvs * 8 + c) * 16 + j) * 64 + d4); acc[c] += r4.x * w0 + r4.y * w1_ + r4.z * w2 + r4.w * w3; } }
        const size_t ch0 = S ? (size_t)BP * CHP + (size_t)b * CHS + cg * 8 : (size_t)b * CHP + cg * 8;
#pragma unroll
        for (int c = 0; c < 8; ++c) F.HID[(((ch0 + c) * 4 + kvh) * 2 + kvs) * 256 + o] = acc[c] + accb;
    }
    __syncthreads();
}
__device__ __forceinline__ void ctx2_phase(Frame& F) {
    LAS float* hs = (LAS float*)F.lds + F.wave * 128;
    const float* w2[2] = {(const float*)F.ka->in[20], (const float*)F.ka->in[23]};
    const int gw = F.vcu * NWAVES + F.wave, NGW = F.G * NWAVES, lane = F.lane;
    constexpr int NT = (BP * NCP + BS * NCS) * 8;
    for (int task = gw; task < NT; task += NGW) {
        const int kv = task & 1, kvh = (task >> 1) & 3, g = task >> 3; const bool S = g >= BP * NCP;
        const int b = S ? (g - BP * NCP) / NCS : g / NCP, n = S ? (g - BP * NCP) % NCS : g % NCP;
        const size_t ch = S ? (size_t)BP * CHP + (size_t)b * CHS + n : (size_t)b * CHP + n;
        const bf16* hl = (const bf16*)(F.ws + WS_HIDB) + ((size_t)kv * NR + ch * 4 + kvh) * 256; const bf16* ht = (const bf16*)(F.ws + WS_HIDB) + ((size_t)kv * NR + (ch + 1) * 4 + kvh) * 256 + 128;
#pragma unroll
        for (int j = 0; j < 2; ++j) { const float x = bf2f(hl[lane + 64 * j]) + bf2f(ht[lane + 64 * j]); hs[lane + 64 * j] = x / (1.f + __expf(-x)); }
        LDS_WAIT();
        float o = 0.f; const float* w = w2[kv] + lane;
        for (int e = 0; e < 128; ++e) o += hs[e] * w[e * 64];
        F.CK[((ch * 2 + kv) * 4 + kvh) * 64 + lane] = o;
        if (!S) { if (kv == 0) ((bf16*)(F.ws + WS_CKB))[(((size_t)b * 4 + kvh) * 256 + n) * 64 + lane] = (bf16)f2bf(o);
                  else ((bf16*)(F.ws + WS_CVT))[(((size_t)b * 4 + kvh) * 64 + lane) * 256 + vpermk(n)] = (bf16)f2bf(o); }
        LDS_WAIT();
    }
}

__device__ __forceinline__ void ctx2_mfma_phase(Frame& F, const bool sample_part  ) {
    const int gw = F.vcu * NWAVES + F.wave, NGW = F.G * NWAVES, lane = F.lane, r = lane & 31, h = lane >> 5;
    const bf16* HB = (const bf16*)(F.ws + WS_HIDB);
    constexpr int TPH = (int)(NR / 32);
    constexpr int TPP = BP * CHP * 4 / 32, TPS = TPH - TPP;
    for (int it = gw; it < 2 * (sample_part ? TPS : TPP); it += NGW) {
        const int kv = it >= (sample_part ? TPS : TPP) ? 1 : 0, tile = sample_part ? (it - kv * TPS) + TPP + kv * TPH : (it - kv * TPP) + kv * TPH;
        const int rho = (tile - kv * TPH) * 32 + r, ch = rho >> 2, kvh = rho & 3;
        const bool S = ch >= BP * CHP; const int c = S ? (ch - BP * CHP) & (CHS - 1) : ch & (CHP - 1), b = S ? (ch - BP * CHP) >> 9 : ch >> 8;
        const bool valid = S ? c < CHS - 1 : c < CHP - 1;
        const size_t rl = (size_t)kv * NR + rho, rt = (size_t)kv * NR + (valid ? rho + 4 : rho);
        const bf16* W2T = (const bf16*)(F.ws + WS_W2T) + (size_t)kv * 64 * 128;
        f32x16 acc[2]; zero16(acc[0]); zero16(acc[1]);
#pragma unroll
        for (int s = 0; s < 8; ++s) { const int kk = 16 * s + 8 * h;
            const v4u a = *(const v4u*)(HB + rl * 256 + kk), t = *(const v4u*)(HB + rt * 256 + 128 + kk);
            float x[8]; x[0] = bflo(a.x) + bflo(t.x); x[1] = bfhi(a.x) + bfhi(t.x); x[2] = bflo(a.y) + bflo(t.y); x[3] = bfhi(a.y) + bfhi(t.y);
            x[4] = bflo(a.z) + bflo(t.z); x[5] = bfhi(a.z) + bfhi(t.z); x[6] = bflo(a.w) + bflo(t.w); x[7] = bfhi(a.w) + bfhi(t.w);
#pragma unroll
            for (int j = 0; j < 8; ++j) x[j] = x[j] * sigmoidf_(x[j]);
            v4u hb; hb.x = cvtpk(x[0], x[1]); hb.y = cvtpk(x[2], x[3]); hb.z = cvtpk(x[4], x[5]); hb.w = cvtpk(x[6], x[7]);
#pragma unroll
            for (int nb = 0; nb < 2; ++nb) acc[nb] = MFMA32(*(const bf16x8*)(W2T + (size_t)(nb * 32 + r) * 128 + kk), __builtin_bit_cast(bf16x8, hb), acc[nb]); }
        if (valid) {
#pragma unroll
            for (int nb = 0; nb < 2; ++nb)
#pragma unroll
                for (int a = 0; a < 4; ++a) { const int n = nb * 32 + 8 * a + 4 * h; const f32x4 v = {acc[nb][4 * a], acc[nb][4 * a + 1], acc[nb][4 * a + 2], acc[nb][4 * a + 3]};
                    *(f32x4*)(F.CK + (((size_t)ch * 2 + kv) * 4 + kvh) * 64 + n) = v;
                    if (!S) { if (kv == 0) { v2u wv_; wv_.x = cvtpk(v.x, v.y); wv_.y = cvtpk(v.z, v.w); *(v2u*)((bf16*)(F.ws + WS_CKB) + (((size_t)b * 4 + kvh) * 256 + c) * 64 + n) = wv_; }
                        else { bf16* vt = (bf16*)(F.ws + WS_CVT) + (((size_t)b * 4 + kvh) * 64 + n) * 256 + vpermk(c);
#pragma unroll
                            for (int j = 0; j < 4; ++j) vt[(size_t)j * 256] = (bf16)f2bf(v[j]); } } }
        }
    }
}

template <bool S, int BR, int KV> __device__ __forceinline__ const void* kvrow(const Frame& F, int b, int kvh, int pos) {
    if (!S) return F.KVB + ((size_t)b * TP + pos) * NKV + BR * 512 + KV * 256 + kvh * 64;
    if (BR == 1) {
        if (pos < PAST) { const int pg = F.page_table[b * NPAGES + (pos >> 7)]; return F.cache_slc + ((size_t)pg * 128 + (pos & 127)) * 512 + KV * 256 + kvh * 64; }
        return F.out + OFF_SLC_S + ((size_t)b * TS + (pos - PAST)) * 512 + KV * 256 + kvh * 64;
    }
    const int i = pos - (PAST - 512);
    if (i < 512) return F.state_win + ((size_t)b * 512 + i) * 512 + KV * 256 + kvh * 64;
    return F.out + OFF_WIN_S + ((size_t)b * 512 + 504 + (i - 512)) * 512 + KV * 256 + kvh * 64;
}
template <bool F32> __device__ __forceinline__ void dots3(const void* krow, const LAS float* qs, float& a0, float& a1, float& a2) {
    if (F32) { const f32x4* p = (const f32x4*)krow;
#pragma unroll 4
        for (int i = 0; i < 16; ++i) { const f32x4 k = p[i]; const f32x4 q0 = *(const LAS f32x4*)(qs + 4 * i), q1 = *(const LAS f32x4*)(qs + 64 + 4 * i), q2 = *(const LAS f32x4*)(qs + 128 + 4 * i);
            a0 += q0.x * k.x + q0.y * k.y + q0.z * k.z + q0.w * k.w; a1 += q1.x * k.x + q1.y * k.y + q1.z * k.z + q1.w * k.w; a2 += q2.x * k.x + q2.y * k.y + q2.z * k.z + q2.w * k.w; } }
    else { const v2u* p = (const v2u*)krow;
#pragma unroll 4
        for (int i = 0; i < 16; ++i) { const v2u w = p[i]; const f32x4 k = {bflo(w.x), bfhi(w.x), bflo(w.y), bfhi(w.y)};
            const f32x4 q0 = *(const LAS f32x4*)(qs + 4 * i), q1 = *(const LAS f32x4*)(qs + 64 + 4 * i), q2 = *(const LAS f32x4*)(qs + 128 + 4 * i);
            a0 += q0.x * k.x + q0.y * k.y + q0.z * k.z + q0.w * k.w; a1 += q1.x * k.x + q1.y * k.y + q1.z * k.z + q1.w * k.w; a2 += q2.x * k.x + q2.y * k.y + q2.z * k.z + q2.w * k.w; } }
}
template <bool S, int BR> __device__ __forceinline__ void nsa_tile(const Frame& F, int b, int kvh, int pos0, int lo, int qpos, const float (&sl)[3],
                                                                   const LAS float* qs, LAS float* sc, float (&m)[3], float (&l)[3], float (&o)[3]) {
    const int lane = F.lane, pos = pos0 + lane; const bool valid = pos >= lo && pos <= qpos;
    if (!__any(valid)) return;
    float s[3] = {NEG_INF, NEG_INF, NEG_INF};
    if (valid) { float a0 = 0.f, a1 = 0.f, a2 = 0.f; dots3<S>(kvrow<S, BR, 0>(F, b, kvh, pos), qs, a0, a1, a2); const float dist = (float)(qpos - pos);
        s[0] = a0 - sl[0] * dist; s[1] = a1 - sl[1] * dist; s[2] = a2 - sl[2] * dist; }
#pragma unroll
    for (int g = 0; g < 3; ++g) { const float mn = fmaxf(m[g], wave_max(s[g])); const float alpha = __expf(m[g] - mn); const float p = valid ? __expf(s[g] - mn) : 0.f;
        l[g] = l[g] * alpha + wave_sum(p); o[g] *= alpha; m[g] = mn; sc[g * 64 + lane] = p; }
    LDS_WAIT();
    const int k0 = lo > pos0 ? lo - pos0 : 0, k1 = qpos - pos0 < 63 ? qpos - pos0 : 63;
    for (int k = k0; k <= k1; ++k) { const void* vr = kvrow<S, BR, 1>(F, b, kvh, pos0 + k);
        const float v = S ? ((const float*)vr)[lane] : bf2f(((const bf16*)vr)[lane]);
        o[0] += sc[k] * v; o[1] += sc[64 + k] * v; o[2] += sc[128 + k] * v; }
    LDS_WAIT();
}
template <bool S> __device__ __forceinline__ void nsa_task(const Frame& F, int b, int t, int kvh, LAS float* wl) {
    constexpr int NC = S ? NCS : NCP, NT = S ? 8 : 4, NSB = S ? 129 : 64, NJ = S ? 3 : 1;
    const int lane = F.lane, row = S ? MP + b * TS + t : b * TP + t, qpos = S ? PAST + t : t, cur = qpos >> 6;
    const bf16* prow = F.PROJ + (size_t)row * NINB_PAD;
    LAS float* qs = wl; LAS float* sc = wl + 192; LAS float* scr = wl + 384; LAS float* pc = wl + 576;
    float sl[3], gt[3][3];
#pragma unroll
    for (int g = 0; g < 3; ++g) { const int h = kvh * 3 + g; sl[g] = h < 8 ? exp2f(-(float)(h + 1)) : exp2f(-((float)(h - 8) + 0.5f));
        qs[g * 64 + lane] = bf2f(prow[h * 64 + lane]) * 0.125f;
#pragma unroll
        for (int j = 0; j < 3; ++j) gt[g][j] = sigmoidf_(bf2f(prow[CONV + h * 3 + j])); }
    LDS_WAIT();
    const float* CKb = F.CK + (S ? ((size_t)BP * CHP + (size_t)b * CHS) : (size_t)b * CHP) * 512;
    float sv[3][NT]; float mx[3] = {NEG_INF, NEG_INF, NEG_INF};
#pragma unroll
    for (int j = 0; j < NT; ++j) { const int n = lane + 64 * j; const bool vis = n < NC && 16 * n + 31 <= qpos;
        float a0 = 0.f, a1 = 0.f, a2 = 0.f;
        if (vis) { dots3<true>(CKb + (size_t)n * 512 + kvh * 64, qs, a0, a1, a2); const float dist = (float)(qpos - (16 * n + 31)); a0 -= sl[0] * dist; a1 -= sl[1] * dist; a2 -= sl[2] * dist; }
        sv[0][j] = vis ? a0 : NEG_INF; sv[1][j] = vis ? a1 : NEG_INF; sv[2][j] = vis ? a2 : NEG_INF;
        mx[0] = fmaxf(mx[0], sv[0][j]); mx[1] = fmaxf(mx[1], sv[1][j]); mx[2] = fmaxf(mx[2], sv[2][j]); }
    float oc[3] = {0.f, 0.f, 0.f};
#pragma unroll
    for (int g = 0; g < 3; ++g) { const float mg = wave_max(mx[g]); float sum = 0.f;
#pragma unroll
        for (int j = 0; j < NT; ++j) { sv[g][j] = sv[g][j] > NEG_INF ? __expf(sv[g][j] - mg) : 0.f; sum += sv[g][j]; }
        sum = wave_sum(sum); const float inv = sum > 0.f ? 1.f / sum : 0.f;
#pragma unroll
        for (int j = 0; j < NT; ++j) pc[g * 512 + lane + 64 * j] = sv[g][j] * inv; }
    LDS_WAIT();
    { int nv = qpos >= 31 ? (qpos - 31) / 16 + 1 : 0; if (nv > NC) nv = NC;
      const float* cv = CKb + 256 + kvh * 64 + lane;
      for (int n = 0; n < nv; ++n) { const float v = cv[(size_t)n * 512]; oc[0] += pc[n] * v; oc[1] += pc[512 + n] * v; oc[2] += pc[1024 + n] * v; } }
#pragma unroll
    for (int jj = 0; jj < NJ; ++jj) { const int sb = lane + 64 * jj;
        if (sb < NSB) { float imp = 0.f;
#pragma unroll
            for (int g = 0; g < 3; ++g)
#pragma unroll
                for (int i = 0; i < 4; ++i) { const int idx = 4 * sb + i; if (idx < NT * 64) imp += pc[g * 512 + idx]; }
            const bool forced = sb == 0 || sb == cur || sb == cur - 1;
            scr[sb] = forced ? 1e4f : (sb <= cur ? imp : NEG_INF); } }
    LDS_WAIT();
    unsigned long long selm[NJ];
#pragma unroll
    for (int jj = 0; jj < NJ; ++jj) { const int sb = lane + 64 * jj; bool sel = false;
        if (sb < NSB) { const float mine = scr[sb]; int cnt = 0;
            for (int j = 0; j < NSB; ++j) { const float ot = scr[j]; cnt += (ot > mine || (ot == mine && j < sb)) ? 1 : 0; }
            sel = cnt < 16; }
        selm[jj] = __ballot(sel); }
    float ms[3] = {NEG_INF, NEG_INF, NEG_INF}, ls[3] = {0.f, 0.f, 0.f}, os[3] = {0.f, 0.f, 0.f};
#pragma unroll
    for (int jj = 0; jj < NJ; ++jj) { unsigned long long mk = selm[jj];
        while (mk) { const int sb = 64 * jj + __ffsll((long long)mk) - 1; mk &= mk - 1;
            if (64 * sb > qpos) continue;
            nsa_tile<S, 1>(F, b, kvh, 64 * sb, 0, qpos, sl, qs, sc, ms, ls, os); } }
    float mw[3] = {NEG_INF, NEG_INF, NEG_INF}, lw[3] = {0.f, 0.f, 0.f}, ow[3] = {0.f, 0.f, 0.f};
    { const int lo = qpos - 512 > 0 ? qpos - 512 : 0;
      for (int i0 = 0; i0 < 9; ++i0) nsa_tile<S, 2>(F, b, kvh, qpos - 512 + 64 * i0, lo, qpos, sl, qs, sc, mw, lw, ow); }
#pragma unroll
    for (int g = 0; g < 3; ++g) { const float v = gt[g][0] * oc[g] + gt[g][1] * os[g] / ls[g] + gt[g][2] * ow[g] / lw[g];
        F.Y[(size_t)row * D + (kvh * 3 + g) * 64 + lane] = (bf16)f2bf(v); }
    LDS_WAIT();
}

template <int MODE, int QS> __device__ __forceinline__ void attn_blk(const LAS bf16* Kb, const LAS bf16* VTb, int vtp, const LAS bf16* Ql  , float slope, float fd0, bool lane_ok,
                                                             float& m, float& l, f32x16 (&o)[2], int r, int h) {
    constexpr float STEP = MODE == 1 ? 16.f : 1.f;
    f32x16 acc;
    if (MODE == 0) zero16(acc);
    else { const float nb0 = -slope * fd0, ss = slope * STEP;
#pragma unroll
        for (int i = 0; i < 16; ++i) acc[i] = fmaf(ss, (float)((i & 3) + 8 * (i >> 2)), nb0); }
#pragma unroll
    for (int s = 0; s < 4; ++s) acc = MFMA32(*(const LAS bf16x8*)(Kb + r * KP + 16 * s + 8 * h), *(const LAS bf16x8*)(Ql + QS * s), acc);
    if (MODE != 0) {
        bool interior = lane_ok && fd0 - STEP * 27.f >= 0.f; if (MODE == 3) interior = interior && fd0 <= 512.f;
        if (!__all(interior)) {
#pragma unroll
            for (int i = 0; i < 16; ++i) { const float dist = fd0 - STEP * (float)((i & 3) + 8 * (i >> 2)); bool ok = lane_ok && dist >= 0.f; if (MODE == 3) ok = ok && dist <= 512.f; acc[i] = ok ? acc[i] : NEG_INF; } }
    }
    float bm = fmaxf(fmaxf(acc[0], acc[1]), fmaxf(acc[2], acc[3]));
#pragma unroll
    for (int i = 4; i < 16; i += 4) bm = fmaxf(bm, fmaxf(fmaxf(acc[i], acc[i + 1]), fmaxf(acc[i + 2], acc[i + 3])));
    bm = fmaxf(bm, __shfl_xor(bm, 32));
    const float mn = fmaxf(m, bm);
    if (__any(mn > m)) { const float ms = mn == NEG_INF ? 0.f : mn, alpha = __builtin_amdgcn_exp2f((m - ms) * LOG2E); l *= alpha; m = mn;
#pragma unroll
        for (int i = 0; i < 16; ++i) { o[0][i] *= alpha; o[1][i] *= alpha; } }
    const float nms = m == NEG_INF ? 0.f : -m * LOG2E;
    float ls = 0.f; float p[16];
#pragma unroll
    for (int i = 0; i < 16; ++i) { p[i] = __builtin_amdgcn_exp2f(fmaf(acc[i], LOG2E, nms)); ls += p[i]; }
    l += ls;
    v4u pw[2];
#pragma unroll
    for (int s = 0; s < 2; ++s) { pw[s].x = cvtpk(p[8 * s], p[8 * s + 1]); pw[s].y = cvtpk(p[8 * s + 2], p[8 * s + 3]); pw[s].z = cvtpk(p[8 * s + 4], p[8 * s + 5]); pw[s].w = cvtpk(p[8 * s + 6], p[8 * s + 7]); }
#pragma unroll
    for (int db = 0; db < 2; ++db)
#pragma unroll
        for (int s = 0; s < 2; ++s) o[db] = MFMA32(*(const LAS bf16x8*)(VTb + (db * 32 + r) * vtp + 16 * s + 8 * h), __builtin_bit_cast(bf16x8, pw[s]), o[db]);
    __builtin_amdgcn_sched_barrier(0);
}
template <int MODE, int QS, bool PS = false> __device__ __forceinline__ void attn_tile64(const LAS bf16* Kt, const LAS bf16* VTt, int vtp, const LAS bf16* Ql, float slope, float fd0, bool lane_ok,
                                                                float& m, float& l, f32x16 (&o)[2], int r, int h, const bool upd = true  ,
                                                                f32x4* ps = nullptr  ) {
    constexpr float STEP = MODE == 1 ? 16.f : 1.f;
    f32x16 acc[2];
    if (MODE == 0) { zero16(acc[0]); zero16(acc[1]); }
    else { const float nb0 = -slope * fd0, ss = slope * STEP, d1 = ss * 32.f;
        { float a0_, a1_; asm("v_fmamk_f32 %0, %2, 0x00000000, %3\n\tv_fmamk_f32 %1, %2, 0x42000000, %3" : "=&v"(a0_), "=v"(a1_) : "v"(ss), "v"(nb0)); acc[0][0] = a0_; acc[1][0] = a1_; }
        { float a0_, a1_; asm("v_fmamk_f32 %0, %2, 0x3f800000, %3\n\tv_fmamk_f32 %1, %2, 0x42040000, %3" : "=&v"(a0_), "=v"(a1_) : "v"(ss), "v"(nb0)); acc[0][1] = a0_; acc[1][1] = a1_; }
        { float a0_, a1_; asm("v_fmamk_f32 %0, %2, 0x40000000, %3\n\tv_fmamk_f32 %1, %2, 0x42080000, %3" : "=&v"(a0_), "=v"(a1_) : "v"(ss), "v"(nb0)); acc[0][2] = a0_; acc[1][2] = a1_; }
        { float a0_, a1_; asm("v_fmamk_f32 %0, %2, 0x40400000, %3\n\tv_fmamk_f32 %1, %2, 0x420c0000, %3" : "=&v"(a0_), "=v"(a1_) : "v"(ss), "v"(nb0)); acc[0][3] = a0_; acc[1][3] = a1_; }
        { float a0_, a1_; asm("v_fmamk_f32 %0, %2, 0x41000000, %3\n\tv_fmamk_f32 %1, %2, 0x42200000, %3" : "=&v"(a0_), "=v"(a1_) : "v"(ss), "v"(nb0)); acc[0][4] = a0_; acc[1][4] = a1_; }
        { float a0_, a1_; asm("v_fmamk_f32 %0, %2, 0x41100000, %3\n\tv_fmamk_f32 %1, %2, 0x42240000, %3" : "=&v"(a0_), "=v"(a1_) : "v"(ss), "v"(nb0)); acc[0][5] = a0_; acc[1][5] = a1_; }
        { float a0_, a1_; asm("v_fmamk_f32 %0, %2, 0x41200000, %3\n\tv_fmamk_f32 %1, %2, 0x42280000, %3" : "=&v"(a0_), "=v"(a1_) : "v"(ss), "v"(nb0)); acc[0][6] = a0_; acc[1][6] = a1_; }
        { float a0_, a1_; asm("v_fmamk_f32 %0, %2, 0x41300000, %3\n\tv_fmamk_f32 %1, %2, 0x422c0000, %3" : "=&v"(a0_), "=v"(a1_) : "v"(ss), "v"(nb0)); acc[0][7] = a0_; acc[1][7] = a1_; }
        { float a0_, a1_; asm("v_fmamk_f32 %0, %2, 0x41800000, %3\n\tv_fmamk_f32 %1, %2, 0x42400000, %3" : "=&v"(a0_), "=v"(a1_) : "v"(ss), "v"(nb0)); acc[0][8] = a0_; acc[1][8] = a1_; }
        { float a0_, a1_; asm("v_fmamk_f32 %0, %2, 0x41880000, %3\n\tv_fmamk_f32 %1, %2, 0x42440000, %3" : "=&v"(a0_), "=v"(a1_) : "v"(ss), "v"(nb0)); acc[0][9] = a0_; acc[1][9] = a1_; }
        { float a0_, a1_; asm("v_fmamk_f32 %0, %2, 0x41900000, %3\n\tv_fmamk_f32 %1, %2, 0x42480000, %3" : "=&v"(a0_), "=v"(a1_) : "v"(ss), "v"(nb0)); acc[0][10] = a0_; acc[1][10] = a1_; }
        { float a0_, a1_; asm("v_fmamk_f32 %0, %2, 0x41980000, %3\n\tv_fmamk_f32 %1, %2, 0x424c0000, %3" : "=&v"(a0_), "=v"(a1_) : "v"(ss), "v"(nb0)); acc[0][11] = a0_; acc[1][11] = a1_; }
        { float a0_, a1_; asm("v_fmamk_f32 %0, %2, 0x41c00000, %3\n\tv_fmamk_f32 %1, %2, 0x42600000, %3" : "=&v"(a0_), "=v"(a1_) : "v"(ss), "v"(nb0)); acc[0][12] = a0_; acc[1][12] = a1_; }
        { float a0_, a1_; asm("v_fmamk_f32 %0, %2, 0x41c80000, %3\n\tv_fmamk_f32 %1, %2, 0x42640000, %3" : "=&v"(a0_), "=v"(a1_) : "v"(ss), "v"(nb0)); acc[0][13] = a0_; acc[1][13] = a1_; }
        { float a0_, a1_; asm("v_fmamk_f32 %0, %2, 0x41d00000, %3\n\tv_fmamk_f32 %1, %2, 0x42680000, %3" : "=&v"(a0_), "=v"(a1_) : "v"(ss), "v"(nb0)); acc[0][14] = a0_; acc[1][14] = a1_; }
        { float a0_, a1_; asm("v_fmamk_f32 %0, %2, 0x41d80000, %3\n\tv_fmamk_f32 %1, %2, 0x426c0000, %3" : "=&v"(a0_), "=v"(a1_) : "v"(ss), "v"(nb0)); acc[0][15] = a0_; acc[1][15] = a1_; } (void)d1; }
#pragma unroll
    for (int s = 0; s < 4; ++s) { const bf16x8 q = *(const LAS bf16x8*)(Ql + QS * s);
        acc[0] = MFMA32(*(const LAS bf16x8*)(Kt + r * KP + 16 * s + 8 * h), q, acc[0]);
        acc[1] = MFMA32(*(const LAS bf16x8*)(Kt + (32 + r) * KP + 16 * s + 8 * h), q, acc[1]); }
    if (MODE != 0) {
        bool interior = lane_ok && fd0 - STEP * 59.f >= 0.f; if (MODE == 3) interior = interior && fd0 <= 512.f;
        if (!__all(interior)) {
#pragma unroll
            for (int kb = 0; kb < 2; ++kb)
#pragma unroll
                for (int i = 0; i < 16; ++i) { const float dist = fd0 - STEP * (float)(32 * kb + (i & 3) + 8 * (i >> 2)); bool ok = lane_ok && dist >= 0.f; if (MODE == 3) ok = ok && dist <= 512.f; acc[kb][i] = ok ? acc[kb][i] : NEG_INF; } }
    }
    if (upd) {
    float bm = NEG_INF;
#pragma unroll
    for (int i = 0; i < 16; i += 2) bm = fmaxf(bm, fmaxf(fmaxf(acc[0][i], acc[0][i + 1]), fmaxf(acc[1][i], acc[1][i + 1])));
    bm = fmaxf(bm, __shfl_xor(bm, 32));
    const float mn = fmaxf(m, bm);
    if (__any(mn > m)) { const float ms = mn == NEG_INF ? 0.f : mn, alpha = __builtin_amdgcn_exp2f((m - ms) * LOG2E); l *= alpha; m = mn;
#pragma unroll
        for (int i = 0; i < 16; ++i) { o[0][i] *= alpha; o[1][i] *= alpha; } }
    }
    const float nms = m == NEG_INF ? 0.f : -m * LOG2E;
    float ls = 0.f; v4u pw[2][2];
#pragma unroll
    for (int kb = 0; kb < 2; ++kb) { float p[16];
#pragma unroll
        for (int i = 0; i < 16; ++i) { float a_; asm("v_fmamk_f32 %0, %1, 0x3fb8aa3b, %2" : "=v"(a_) : "v"(acc[kb][i]), "v"(nms));
            p[i] = __builtin_amdgcn_exp2f(a_); if (!PS) ls += p[i]; }
        if (PS) {
#pragma unroll
            for (int a = 0; a < 4; ++a) { const float s4 = (p[4 * a] + p[4 * a + 1]) + (p[4 * a + 2] + p[4 * a + 3]); ps[kb][a] = s4; ls += s4; } }
#pragma unroll
        for (int s = 0; s < 2; ++s) { pw[kb][s].x = cvtpk(p[8 * s], p[8 * s + 1]); pw[kb][s].y = cvtpk(p[8 * s + 2], p[8 * s + 3]); pw[kb][s].z = cvtpk(p[8 * s + 4], p[8 * s + 5]); pw[kb][s].w = cvtpk(p[8 * s + 6], p[8 * s + 7]); } }
    l += ls;
#pragma unroll
    for (int kb = 0; kb < 2; ++kb)
#pragma unroll
        for (int s = 0; s < 2; ++s)
#pragma unroll
            for (int db = 0; db < 2; ++db) o[db] = MFMA32(*(const LAS bf16x8*)(VTt + (db * 32 + r) * vtp + 32 * kb + 16 * s + 8 * h), __builtin_bit_cast(bf16x8, pw[kb][s]), o[db]);
    __builtin_amdgcn_sched_barrier(0);
}
__device__ __forceinline__ v4u qscale8(const v4u& q) { v4u r_; r_.x = cvtpk(bflo(q.x) * 0.125f, bfhi(q.x) * 0.125f); r_.y = cvtpk(bflo(q.y) * 0.125f, bfhi(q.y) * 0.125f); r_.z = cvtpk(bflo(q.z) * 0.125f, bfhi(q.z) * 0.125f); r_.w = cvtpk(bflo(q.w) * 0.125f, bfhi(q.w) * 0.125f); return r_; }
__device__ __forceinline__ void memattn_mfma_phase(Frame& F, int l, int ldp, int qoff, unsigned* ctr  ) {
    LAS bf16* Ks = (LAS bf16*)F.lds; LAS bf16* VTs = Ks + 256 * KP; constexpr int VTP = 264;
    const int lane = F.lane, r = lane & 31, h = lane >> 5, tid = F.tid;
    constexpr int NU = BP * 4 * 16 + BS * 4;
    volatile LAS int* qid = (volatile LAS int*)(F.lds + 123968);
    for (int u = F.vcu;; u += F.G) {
        if (ctr) { __syncthreads(); if (F.wave == 0 && lane_id() == 0) *qid = (int)atomicAdd(ctr, 1u); __syncthreads(); u = *qid; }
        if (u >= NU) break;
        int row0, nrows, hd; const bool S = u >= BP * 4 * 16;
        if (!S) { const int b = u >> 6, ch = u & 15; hd = (u >> 4) & 3; row0 = b * TP + ch * 256; nrows = 256; } else { const int v = u - BP * 4 * 16; hd = v & 3; row0 = MP + (v >> 2) * TS; nrows = TS; }
        v4u qv_[4];
        { const int rq = F.wave * 32 + r, row = row0 + (rq < nrows ? rq : 0);
#pragma unroll
          for (int s = 0; s < 4; ++s) qv_[s] = *(const v4u*)(F.PROJ + (size_t)row * ldp + qoff + hd * 64 + 16 * s + 8 * h); }
        __syncthreads();
        if (!S) { const int b = u >> 6, ch = u & 15; hd = (u >> 4) & 3; row0 = b * TP + ch * 256; nrows = 256;
            const bf16* kg = (const bf16*)(F.ws + WS_MKB) + ((size_t)l * 1024 + b * 256) * 256 + hd * 64;
            const bf16* vg = (const bf16*)(F.ws + WS_MVT) + ((((size_t)l * 4 + b) * 4 + hd) * 64) * 256;
            v4u kb_[4], vb_[4];
#pragma unroll
            for (int it = 0; it < 4; ++it) { const int i = tid + 512 * it; kb_[it] = *(const v4u*)(kg + (size_t)(i >> 3) * 256 + (i & 7) * 8); vb_[it] = *(const v4u*)(vg + (size_t)(i >> 5) * 256 + (i & 31) * 8); }
#pragma unroll
            for (int it = 0; it < 4; ++it) { const int i = tid + 512 * it; *(LAS v4u*)(Ks + (i >> 3) * KP + (i & 7) * 8) = kb_[it]; *(LAS v4u*)(VTs + (i >> 5) * VTP + (i & 31) * 8) = vb_[it]; } }
        else { const int v = u - BP * 4 * 16, b = v >> 2; hd = v & 3; row0 = MP + b * TS; nrows = TS;
            const float* kv = F.cache_mem + ((size_t)l * BS + b) * NMEM * 512 + hd * 64;
            f32x4 kk_[4][2], vv_[4][2];
#pragma unroll
            for (int it = 0; it < 4; ++it) { const int i = tid + 512 * it; const float* kp = kv + (size_t)(i >> 3) * 512 + (i & 7) * 8;
                kk_[it][0] = *(const f32x4*)kp; kk_[it][1] = *(const f32x4*)(kp + 4); vv_[it][0] = *(const f32x4*)(kp + 256); vv_[it][1] = *(const f32x4*)(kp + 260); }
#pragma unroll
            for (int it = 0; it < 4; ++it) { const int i = tid + 512 * it, rr = i >> 3, c = i & 7;
                *(LAS v4u*)(Ks + rr * KP + c * 8) = pack8(kk_[it][0], kk_[it][1]); LAS bf16* vt = VTs + (c * 8) * VTP + vpermk(rr);
#pragma unroll
                for (int j = 0; j < 4; ++j) { vt[j * VTP] = (bf16)f2bf(vv_[it][0][j]); vt[(j + 4) * VTP] = (bf16)f2bf(vv_[it][1][j]); } } }
        __syncthreads();
        if (F.wave * 32 < nrows) {
            const int rq = F.wave * 32 + r, row = row0 + (rq < nrows ? rq : 0);
            LAS bf16* Ql = VTs + 64 * VTP + (F.wave * 32 + r) * KP + 8 * h;
#pragma unroll
            for (int s = 0; s < 4; ++s) *(LAS v4u*)(Ql + 16 * s) = qscale8(qv_[s]);
            float m = NEG_INF, ll = 0.f; f32x16 o[2]; zero16(o[0]); zero16(o[1]);
            for (int kt = 0; kt < 4; ++kt) attn_tile64<0, 16>(Ks + kt * 64 * KP, VTs + kt * 64, VTP, Ql, 0.f, 0.f, true, m, ll, o, r, h);
            ll += __shfl_xor(ll, 32); const float inv = 1.f / ll;
            if (rq < nrows) {
#pragma unroll
                for (int db = 0; db < 2; ++db)
#pragma unroll
                    for (int a = 0; a < 4; ++a) { v2u w; w.x = cvtpk(o[db][4 * a] * inv, o[db][4 * a + 1] * inv); w.y = cvtpk(o[db][4 * a + 2] * inv, o[db][4 * a + 3] * inv);
                        *(v2u*)(F.Y + (size_t)row * D + CONV + hd * 64 + db * 32 + 8 * a + 4 * h) = w; } }
        }
    }
    __syncthreads();
}

struct TileSrc { const bf16* k; size_t ks; const bf16* vt; size_t vs; };
template <int BR> __device__ __forceinline__ TileSrc tile_src(const Frame& F, int b, int kvh, int id) {
    TileSrc t;
    if (BR == 0) { t.k = (const bf16*)(F.ws + WS_CKB) + (((size_t)b * 4 + kvh) * 256 + 64 * id) * 64; t.ks = 64; t.vt = (const bf16*)(F.ws + WS_CVT) + (((size_t)b * 4 + kvh) * 64) * 256 + 64 * id; t.vs = 256; }
    else { const size_t hb = (((size_t)(BR - 1) * 4 + b) * 4 + kvh); t.k = (const bf16*)(F.ws + WS_KTB) + ((hb << 12) + 64 * id) * 64; t.ks = 64; t.vt = (const bf16*)(F.ws + WS_VTB) + ((hb * 64 + id) << 12); t.vs = 64; }
    return t;
}
__device__ __forceinline__ void tile_issue(const TileSrc& t, int tid_, v4u& kr, v4u& vr) { const unsigned tid = ((unsigned)tid_ & ~63u) | (unsigned)lane_id();
    const unsigned rr = tid >> 3, c = tid & 7u;
    kr = *(const v4u*)((const char*)t.k + (rr * (unsigned)t.ks + c * 8u) * 2u); vr = *(const v4u*)((const char*)t.vt + (rr * (unsigned)t.vs + c * 8u) * 2u); }
__device__ __forceinline__ void tile_commit(LAS bf16* Kt, LAS bf16* VTt, int tid, const v4u& kr, const v4u& vr) { const int rr = tid >> 3, c = tid & 7; *(LAS v4u*)(Kt + rr * KP + c * 8) = kr; *(LAS v4u*)(VTt + rr * KP + c * 8) = vr; }

template <int BR> __device__ __forceinline__ void nsa_branch(const Frame& F, int b, int kvh, unsigned long long mask, LAS bf16* Kt, LAS bf16* VTt, const LAS bf16* Ql, const float (&sl)[3],
                                                             int t, int tw0, unsigned selE, unsigned selO, unsigned wvE, unsigned wvO, float (&m)[3], float (&l)[3], f32x16 (&o)[3][2],
                                                             v4u kr, v4u vr, const int pre_id  ) {
    const int tid = F.tid, r = F.lane & 31, h = F.lane >> 5;
    bool first = true;
    constexpr int BUF2 = (118784 - 0) / 2;
    int cur = 0;
    if (mask) { const int top = 63 - __clzll((long long)mask); if (top != pre_id) { const TileSrc ts = tile_src<BR>(F, b, kvh, top); tile_issue(ts, tid, kr, vr); }
        __syncthreads();
        tile_commit(Kt, VTt, tid, kr, vr);
        const unsigned long long m2 = mask & ~(1ull << (63 - __clzll((long long)mask)));
        if (m2) { const TileSrc t2 = tile_src<BR>(F, b, kvh, 63 - __clzll((long long)m2)); tile_issue(t2, tid, kr, vr); } }
    while (mask) {
        const int id = 63 - __clzll((long long)mask); mask &= ~(1ull << id);
        __syncthreads();
        if (mask) { tile_commit(Kt + (cur ^ 1) * BUF2, VTt + (cur ^ 1) * BUF2, tid, kr, vr);
            const unsigned long long m2 = mask & ~(1ull << (63 - __clzll((long long)mask)));
            if (m2) { const TileSrc t2 = tile_src<BR>(F, b, kvh, 63 - __clzll((long long)m2)); tile_issue(t2, tid, kr, vr); } }
#if STAG_SLEEP
        if (F.wave >= 4) __builtin_amdgcn_s_sleep(STAG_SLEEP);
#endif
        const LAS bf16* Kc = Kt + cur * BUF2; const LAS bf16* Vc = VTt + cur * BUF2; cur ^= 1;
        bool wave_in, lane_ok = true;
        if (BR == 1) { const unsigned wb = (id & 1) ? wvO : wvE; wave_in = (wb >> (id >> 1)) & 1u; const unsigned lb = (id & 1) ? selO : selE; lane_ok = (lb >> (id >> 1)) & 1u; }
        else wave_in = (64 * id + 63 >= tw0 - 512) && (64 * id <= tw0 + 31);
        if (wave_in) { const float fd0 = (float)(t - (64 * id + 4 * h));
            const bool any = BR == 1 ? (lane_ok && fd0 >= 0.f) : (fd0 >= 0.f && fd0 - 59.f <= 512.f);
            if (__any(any)) {
#pragma unroll
                for (int g = 0; g < 3; ++g) attn_tile64<BR == 1 ? 2 : 3, 512>(Kc, Vc, KP, Ql + g * 2048, sl[g], fd0, lane_ok, m[g], l[g], o[g], r, h, first);
                first = false; }
        }
    }
}
__device__ __forceinline__ void cmp_scores(f32x16& acc, const LAS bf16* Kb, const LAS bf16* Qg, float slope, float fd0, int r, int h) {
    const float nb0 = -slope * fd0, ss = slope * 16.f;
#pragma unroll
    for (int i = 0; i < 16; ++i) acc[i] = fmaf(ss, (float)((i & 3) + 8 * (i >> 2)), nb0);
#pragma unroll
    for (int s = 0; s < 4; ++s) acc = MFMA32(*(const LAS bf16x8*)(Kb + r * KP + 16 * s + 8 * h), *(const LAS bf16x8*)(Qg + 512 * s), acc);
    if (!__all(fd0 - 432.f >= 0.f)) {
#pragma unroll
        for (int i = 0; i < 16; ++i) acc[i] = fd0 - 16.f * (float)((i & 3) + 8 * (i >> 2)) >= 0.f ? acc[i] : NEG_INF; }
}
__device__ __forceinline__ void nsa_prompt_unit(Frame& F, int unit) {
    const int lane = lane_id();
    const int tid = F.wave * 64 + lane, r = lane & 31, h = lane >> 5, w = F.wave;
    const int b = unit >> 6, kvh = (unit >> 4) & 3, u = unit & 15, t0 = u * 256, tw0 = t0 + 32 * w, t = tw0 + r, row = b * TP + t, cur = tw0 >> 6;
    LAS bf16* Kt = (LAS bf16*)F.lds; LAS bf16* VTt = Kt + 64 * KP; volatile LAS unsigned* uni = (volatile LAS unsigned*)(F.lds + 2 * 64 * KP * 2);
    const bf16* prow = F.PROJ + (size_t)row * NINB_PAD;
    float sl[3];
    const int ntile = (t0 + 255 - 31) / 16 / 64 + 1;
    v4u pkr0, pvr0; { const TileSrc ts = tile_src<0>(F, b, kvh, ntile - 1); tile_issue(ts, tid, pkr0, pvr0); }
    LAS bf16* Ql = (LAS bf16*)(F.lds + 20480) + (w * 12 * 64 + lane) * 8;
#pragma unroll
    for (int g = 0; g < 3; ++g) { const int hh = kvh * 3 + g; sl[g] = hh < 8 ? exp2f(-(float)(hh + 1)) : exp2f(-((float)(hh - 8) + 0.5f));
#pragma unroll
        for (int s = 0; s < 4; ++s) *(LAS v4u*)(Ql + (g * 4 + s) * 512) = qscale8(*(const v4u*)(prow + hh * 64 + 16 * s + 8 * h)); }
    if (tid < 2) uni[tid] = 0u;
    float mc[3] = {NEG_INF, NEG_INF, NEG_INF}, lc[3] = {0.f, 0.f, 0.f};
    f32x16 o[3][2];
#pragma unroll
    for (int g = 0; g < 3; ++g) { zero16(o[g][0]); zero16(o[g][1]); }
    { v4u pkr = pkr0, pvr = pvr0;
      for (int j = ntile - 1; j >= 0; --j) {
        __syncthreads(); tile_commit(Kt, VTt, tid, pkr, pvr); __syncthreads();
        if (j > 0) { const TileSrc ts = tile_src<0>(F, b, kvh, j - 1); tile_issue(ts, tid, pkr, pvr); }
        if (1024 * j <= tw0) { const float fd0 = (float)(t - 31 - 1024 * j - 64 * h);
#pragma unroll
            for (int g = 0; g < 3; ++g) { f32x4 ps[2];
                attn_tile64<1, 512, true>(Kt, VTt, KP, Ql + g * 2048, sl[g], fd0, true, mc[g], lc[g], o[g], r, h, true, ps);
                const int ln = lane_id(); const size_t sb_ = (size_t)(unit * 8 + w) * 24 + (j * 3 + g) * 2;
                f32x4* sp = (f32x4*)(F.ws + WS_IMPS) + sb_ * 64 + ln; sp[0] = ps[0]; sp[64] = ps[1];
                ((float*)(F.ws + WS_IMPM))[((size_t)(unit * 8 + w) * 12 + j * 3 + g) * 64 + ln] = mc[g]; } }
      } }
    float il[3];
#pragma unroll
    for (int g = 0; g < 3; ++g) { const float lt = lc[g] + __shfl_xor(lc[g], 32); il[g] = lt > 0.f ? __builtin_amdgcn_rcpf(lt) : 0.f; }
    bf16 gate_[3];
#pragma unroll
    for (int g = 0; g < 3; ++g) { const int ln = lane_id(); gate_[g] = F.PROJ[(size_t)(b * TP + tw0 + (ln & 31)) * NINB_PAD + CONV + (kvh * 3 + g) * 3 + 0]; }
    __builtin_amdgcn_sched_barrier(0);
#pragma unroll
    for (int g = 0; g < 3; ++g) { const int ln = lane_id(); const float gc = il[g] * sigmoidf_(bf2f(gate_[g]));
        v2u* oa = (v2u*)(F.ws + WS_OACC) + ((size_t)(unit * 8 + w) * 24) * 64 + ln;
#pragma unroll
        for (int db = 0; db < 2; ++db)
#pragma unroll
            for (int a = 0; a < 4; ++a) { v2u pk_; pk_.x = cvtpk(o[g][db][4 * a] * gc, o[g][db][4 * a + 1] * gc); pk_.y = cvtpk(o[g][db][4 * a + 2] * gc, o[g][db][4 * a + 3] * gc); oa[((g * 2 + db) * 4 + a) * 64] = pk_; } }
    __builtin_amdgcn_sched_barrier(0);
    float imp[32];
#pragma unroll
    for (int i = 0; i < 32; ++i) imp[i] = 0.f;
    { float mr[4][3];
#pragma unroll
      for (int j = 0; j < 4; ++j) if (j < ntile && 1024 * j <= tw0) { const int ln = lane_id();
#pragma unroll
          for (int g = 0; g < 3; ++g) mr[j][g] = ((const float*)(F.ws + WS_IMPM))[((size_t)(unit * 8 + w) * 12 + j * 3 + g) * 64 + ln]; }
      __builtin_amdgcn_sched_barrier(0);
#pragma unroll
      for (int j = 0; j < 4; ++j) if (j < ntile && 1024 * j <= tw0) {
        const int ln = lane_id(); f32x4 pv[3][2];
#pragma unroll
        for (int g = 0; g < 3; ++g) { const f32x4* sp = (const f32x4*)(F.ws + WS_IMPS) + ((size_t)(unit * 8 + w) * 24 + (j * 3 + g) * 2) * 64 + ln; pv[g][0] = sp[0]; pv[g][1] = sp[64]; }
        __builtin_amdgcn_sched_barrier(0);
#pragma unroll
        for (int g = 0; g < 3; ++g) { const float sc_ = il[g] > 0.f ? il[g] * __builtin_amdgcn_exp2f((mr[j][g] - mc[g]) * LOG2E) : 0.f;
#pragma unroll
            for (int kb = 0; kb < 2; ++kb)
#pragma unroll
                for (int a = 0; a < 4; ++a) imp[8 * j + 4 * kb + a] = fmaf(pv[g][kb][a], sc_, imp[8 * j + 4 * kb + a]); } } }
    const int cmax_ = (t0 + 255) >> 6;
    v4u pkr, pvr; { const TileSrc ts = tile_src<1>(F, b, kvh, cmax_); tile_issue(ts, tid, pkr, pvr); }
    unsigned selE, selO, wvE, wvO;
    for (int rep_ = 0; rep_ < REP_TOPK; ++rep_)
    {
      unsigned key[32];
#pragma unroll
      for (int i = 0; i < 32; ++i) { const int sb = 2 * i + h; const bool forced = sb == 0 || sb == cur || sb == cur - 1; key[i] = forced ? 0xFFFFFFFFu : (sb <= cur ? __float_as_uint(imp[i]) + 1u : 0u); }
      unsigned T = 0u; int cntT = 64;
#pragma unroll 1
      for (int bit = 30; bit >= 0; --bit) { const unsigned cand = T | (1u << bit); int c = 0;
#pragma unroll
          for (int i = 0; i < 32; ++i) c += key[i] >= cand ? 1 : 0;
          c += __shfl_xor(c, 32);
          T = c >= 16 ? cand : T; cntT = c >= 16 ? c : cntT;
          if (__all(cntT == 16)) break; }
      unsigned gt = 0u, eq = 0u;
#pragma unroll
      for (int i = 0; i < 32; ++i) { gt |= (key[i] > T ? 1u : 0u) << i; eq |= (key[i] == T ? 1u : 0u) << i; }
      int ngt = __popc(gt); ngt += __shfl_xor(ngt, 32);
      const int need = 16 - ngt; const unsigned eqo = (unsigned)__shfl_xor((int)eq, 32);
      unsigned bits = gt;
#pragma unroll
      for (int i = 0; i < 32; ++i) { const unsigned lo_m = (1u << i) - 1u, lo_o = h ? (2u << i) - 1u : lo_m;
          const int below = __popc(eq & lo_m) + __popc(eqo & lo_o);
          bits |= (((eq >> i) & 1u) && below < need ? 1u : 0u) << i; }
      const unsigned other = (unsigned)__shfl_xor((int)bits, 32);
      selE = h ? other : bits; selO = h ? bits : other; }
    wvE = selE; wvO = selO;
#pragma unroll
    for (int off = 1; off < 32; off <<= 1) { wvE |= (unsigned)__shfl_xor((int)wvE, off); wvO |= (unsigned)__shfl_xor((int)wvO, off); }
    wvE = (unsigned)__builtin_amdgcn_readfirstlane((int)wvE); wvO = (unsigned)__builtin_amdgcn_readfirstlane((int)wvO);
    __syncthreads();
    if (lane == 0) { atomicOr((unsigned*)&uni[0], wvE); atomicOr((unsigned*)&uni[1], wvO); }
    __syncthreads();
    unsigned long long smask;
    { unsigned long long e = uni[0], od = uni[1];
      e = (e | (e << 16)) & 0x0000FFFF0000FFFFull; e = (e | (e << 8)) & 0x00FF00FF00FF00FFull; e = (e | (e << 4)) & 0x0F0F0F0F0F0F0F0Full; e = (e | (e << 2)) & 0x3333333333333333ull; e = (e | (e << 1)) & 0x5555555555555555ull;
      od = (od | (od << 16)) & 0x0000FFFF0000FFFFull; od = (od | (od << 8)) & 0x00FF00FF00FF00FFull; od = (od | (od << 4)) & 0x0F0F0F0F0F0F0F0Full; od = (od | (od << 2)) & 0x3333333333333333ull; od = (od | (od << 1)) & 0x5555555555555555ull;
      smask = e | (od << 1);
      const int cmax = (t0 + 255) >> 6; if (cmax < 63) smask &= (2ull << cmax) - 1ull; }
    float mm[3] = {NEG_INF, NEG_INF, NEG_INF}, ll[3] = {0.f, 0.f, 0.f};
#pragma unroll
    for (int g = 0; g < 3; ++g) { zero16(o[g][0]); zero16(o[g][1]); }
    nsa_branch<1>(F, b, kvh, smask, Kt, VTt, Ql, sl, t, tw0, selE, selO, wvE, wvO, mm, ll, o, pkr, pvr, cmax_);
    { const TileSrc ts = tile_src<2>(F, b, kvh, cmax_); tile_issue(ts, tid, pkr, pvr); }
    { bf16 gs_[3]; v2u qc_[2][4];
#pragma unroll
      for (int g = 0; g < 3; ++g) { const int ln = lane_id(); gs_[g] = F.PROJ[(size_t)(b * TP + tw0 + (ln & 31)) * NINB_PAD + CONV + (kvh * 3 + g) * 3 + 1]; }
      { const int ln = lane_id(); const v2u* oa = (const v2u*)(F.ws + WS_OACC) + ((size_t)(unit * 8 + w) * 24) * 64 + ln;
#pragma unroll
        for (int db = 0; db < 2; ++db)
#pragma unroll
            for (int a = 0; a < 4; ++a) qc_[db][a] = oa[(db * 4 + a) * 64]; }
#pragma unroll
      for (int g = 0; g < 3; ++g) { const int ln = lane_id(); const float lt = ll[g] + __shfl_xor(ll[g], 32);
        v2u* oa = (v2u*)(F.ws + WS_OACC) + ((size_t)(unit * 8 + w) * 24) * 64 + ln;
        v2u qn_[2][4];
        if (g < 2) {
#pragma unroll
            for (int db = 0; db < 2; ++db)
#pragma unroll
                for (int a = 0; a < 4; ++a) qn_[db][a] = oa[(((g + 1) * 2 + db) * 4 + a) * 64]; }
        __builtin_amdgcn_sched_barrier(0);
        const float sc_ = sigmoidf_(bf2f(gs_[g])) / lt;
#pragma unroll
        for (int db = 0; db < 2; ++db)
#pragma unroll
            for (int a = 0; a < 4; ++a) { const v2u q_ = qc_[db][a]; v2u pk_;
                pk_.x = cvtpk(bflo(q_.x) + o[g][db][4 * a] * sc_, bfhi(q_.x) + o[g][db][4 * a + 1] * sc_); pk_.y = cvtpk(bflo(q_.y) + o[g][db][4 * a + 2] * sc_, bfhi(q_.y) + o[g][db][4 * a + 3] * sc_); oa[((g * 2 + db) * 4 + a) * 64] = pk_; }
        if (g < 2) {
#pragma unroll
            for (int db = 0; db < 2; ++db)
#pragma unroll
                for (int a = 0; a < 4; ++a) qc_[db][a] = qn_[db][a]; }
        __builtin_amdgcn_sched_barrier(0); } }
    for (int rep_ = 0; rep_ < REP_WIN; ++rep_) {
#pragma unroll
    for (int g = 0; g < 3; ++g) { mm[g] = NEG_INF; ll[g] = 0.f; zero16(o[g][0]); zero16(o[g][1]); }
    { const int lo_ = (t0 - 512 > 0 ? t0 - 512 : 0) >> 6, hi_ = (t0 + 255) >> 6;
      const unsigned long long wmask = (hi_ >= 63 ? ~0ull : ((2ull << hi_) - 1ull)) & ~((1ull << lo_) - 1ull);
      nsa_branch<2>(F, b, kvh, wmask, Kt, VTt, Ql, sl, t, tw0, 0u, 0u, 0u, 0u, mm, ll, o, pkr, pvr, REP_WIN == 1 ? cmax_ : -1); } }
    { bf16 gs_[3]; v2u qc_[2][4];
#pragma unroll
      for (int g = 0; g < 3; ++g) { const int ln = lane_id(); gs_[g] = F.PROJ[(size_t)(b * TP + tw0 + (ln & 31)) * NINB_PAD + CONV + (kvh * 3 + g) * 3 + 2]; }
      { const int ln = lane_id(); const v2u* oa = (const v2u*)(F.ws + WS_OACC) + ((size_t)(unit * 8 + w) * 24) * 64 + ln;
#pragma unroll
        for (int db = 0; db < 2; ++db)
#pragma unroll
            for (int a = 0; a < 4; ++a) qc_[db][a] = oa[(db * 4 + a) * 64]; }
#pragma unroll
      for (int g = 0; g < 3; ++g) { const int ln = lane_id(), row2 = b * TP + tw0 + (ln & 31), h2 = ln >> 5; const float lt = ll[g] + __shfl_xor(ll[g], 32);
        const v2u* oa = (const v2u*)(F.ws + WS_OACC) + ((size_t)(unit * 8 + w) * 24) * 64 + ln;
        v2u qn_[2][4];
        if (g < 2) {
#pragma unroll
            for (int db = 0; db < 2; ++db)
#pragma unroll
                for (int a = 0; a < 4; ++a) qn_[db][a] = oa[(((g + 1) * 2 + db) * 4 + a) * 64]; }
        __builtin_amdgcn_sched_barrier(0);
        const float sc_ = sigmoidf_(bf2f(gs_[g])) / lt;
#pragma unroll
        for (int db = 0; db < 2; ++db)
#pragma unroll
            for (int a = 0; a < 4; ++a) { const v2u q_ = qc_[db][a]; const f32x4 v = (f32x4){bflo(q_.x), bfhi(q_.x), bflo(q_.y), bfhi(q_.y)} + (f32x4){o[g][db][4 * a], o[g][db][4 * a + 1], o[g][db][4 * a + 2], o[g][db][4 * a + 3]} * sc_;
                v2u wv_; wv_.x = cvtpk(v.x, v.y); wv_.y = cvtpk(v.z, v.w);
                *(v2u*)(F.Y + (size_t)row2 * D + (kvh * 3 + g) * 64 + db * 32 + 8 * a + 4 * h2) = wv_; }
        if (g < 2) {
#pragma unroll
            for (int db = 0; db < 2; ++db)
#pragma unroll
                for (int a = 0; a < 4; ++a) qc_[db][a] = qn_[db][a]; }
        __builtin_amdgcn_sched_barrier(0); } }
    __syncthreads();
}

constexpr int SU_K = 0, SU_VT = 36864, SU_OW = 70656, SU_OUT = 103424, SU_MW = 111616, SU_ML = 113664, SU_IMP = 113920, SU_SEL = 118144, SU_LIST = 119296, SU_Q = 119872, SU_QID = 123968, SU_VTP = 264;
static_assert(SU_QID + 64 <= MISC_OFF, "sample-unit LDS map");
template <int BR> __device__ __forceinline__ const float* su_row(const Frame& F, int b, int kvh, int chunk, int slot, const volatile LAS int* list, int count) {
    if (BR == 0) { const int n = chunk * 256 + slot; if (n >= NCS) return nullptr; return F.CK + ((size_t)BP * CHP + (size_t)b * CHS + n) * 512 + kvh * 64; }
    if (BR == 1) { const int e = chunk * 4 + (slot >> 6); if (e >= count) return nullptr; const int pos = 64 * list[e] + (slot & 63);
        if (pos < PAST) { const int pg = F.page_table[b * NPAGES + (pos >> 7)]; return F.cache_slc + ((size_t)pg * 128 + (pos & 127)) * 512 + kvh * 64; }
        if (pos < PAST + TS) return F.out + OFF_SLC_S + ((size_t)b * TS + (pos - PAST)) * 512 + kvh * 64;
        return nullptr; }
    const int i = chunk * 256 + slot;
    if (i < 512) return F.state_win + ((size_t)b * 512 + i) * 512 + kvh * 64;
    if (i < 520) return F.out + OFF_WIN_S + ((size_t)b * 512 + 504 + (i - 512)) * 512 + kvh * 64;
    return nullptr;
}
template <int BR> __device__ __forceinline__ void su_stage(const Frame& F, int b, int kvh, int chunk, int tid, const volatile LAS int* list, int count) {
    LAS bf16* Ks = (LAS bf16*)(F.lds + SU_K); LAS bf16* VTs = (LAS bf16*)(F.lds + SU_VT);
    const float* rp[4];
#pragma unroll
    for (int it = 0; it < 4; ++it) rp[it] = su_row<BR>(F, b, kvh, chunk, (tid + 512 * it) >> 3, list, count);
    f32x4 kk[4][2], vv[4][2];
#pragma unroll
    for (int it = 0; it < 4; ++it) { const int c = tid & 7;
        if (rp[it]) { kk[it][0] = *(const f32x4*)(rp[it] + c * 8); kk[it][1] = *(const f32x4*)(rp[it] + c * 8 + 4); vv[it][0] = *(const f32x4*)(rp[it] + 256 + c * 8); vv[it][1] = *(const f32x4*)(rp[it] + 256 + c * 8 + 4); }
        else { kk[it][0] = kk[it][1] = vv[it][0] = vv[it][1] = (f32x4){0.f, 0.f, 0.f, 0.f}; } }
#pragma unroll
    for (int it = 0; it < 4; ++it) { const int slot = (tid + 512 * it) >> 3, c = tid & 7;
        *(LAS v4u*)(Ks + slot * KP + c * 8) = pack8(kk[it][0], kk[it][1]);
        LAS bf16* vt = VTs + (c * 8) * SU_VTP + vpermk(slot);
#pragma unroll
        for (int j = 0; j < 4; ++j) { vt[j * SU_VTP] = (bf16)f2bf(vv[it][0][j]); vt[(j + 4) * SU_VTP] = (bf16)f2bf(vv[it][1][j]); } }
}
template <bool STORE_ML> __device__ __forceinline__ void su_merge(const Frame& F, int w, int lane, float m, float l, const f32x16 (&o)[2], float gate) {
    LAS float* oW = (LAS float*)(F.lds + SU_OW); LAS float* outL = (LAS float*)(F.lds + SU_OUT); LAS float* mW = (LAS float*)(F.lds + SU_MW); LAS float* lW = mW + 256; LAS float* ML = (LAS float*)(F.lds + SU_ML);
    const int col = lane & 31;
    l += __shfl_xor(l, 32);
    if (lane < 32) { mW[w * 32 + col] = m; lW[w * 32 + col] = l; }
#pragma unroll
    for (int db = 0; db < 2; ++db) {
        __syncthreads();
#pragma unroll
        for (int i = 0; i < 16; ++i) oW[(w * 16 + i) * 64 + lane] = o[db][i];
        __syncthreads();
        float Mx = NEG_INF;
#pragma unroll
        for (int ww = 0; ww < 8; ++ww) Mx = fmaxf(Mx, mW[ww * 32 + col]);
        const float Ms = Mx == NEG_INF ? 0.f : Mx; float L = 0.f, sc[8];
#pragma unroll
        for (int ww = 0; ww < 8; ++ww) { sc[ww] = __expf(mW[ww * 32 + col] - Ms); L += lW[ww * 32 + col] * sc[ww]; }
        const float invL = L > 0.f ? 1.f / L : 0.f;
        if (STORE_ML && db == 0 && w == 0 && lane < 32) { ML[col] = Ms; ML[32 + col] = invL; }
#pragma unroll
        for (int s2 = 0; s2 < 2; ++s2) { const int s = 2 * w + s2; float a = 0.f;
#pragma unroll
            for (int ww = 0; ww < 8; ++ww) a += oW[(ww * 16 + s) * 64 + lane] * sc[ww];
            outL[(db * 16 + s) * 64 + lane] += gate * a * invL; }
    }
    __syncthreads();
}
__device__ __forceinline__ void nsa_sample_unit(Frame& F, int su) {
    const int b = su >> 2, kvh = su & 3, lane = lane_id(), w = F.wave, tid = w * 64 + lane, r = lane & 31, h = lane >> 5;
    const int qi = r & 7, gq = r >> 3; const bool colok = r < 24; const int gg = colok ? gq : 0, head = kvh * 3 + gg, qpos = PAST + qi, row = MP + b * TS + qi;
    const float slope = head < 8 ? exp2f(-(float)(head + 1)) : exp2f(-((float)(head - 8) + 0.5f));
    LAS bf16* Ks = (LAS bf16*)(F.lds + SU_K); LAS bf16* VTs = (LAS bf16*)(F.lds + SU_VT);
    LAS float* outL = (LAS float*)(F.lds + SU_OUT); LAS float* ML = (LAS float*)(F.lds + SU_ML); LAS float* impL = (LAS float*)(F.lds + SU_IMP);
    volatile LAS unsigned char* selL = (volatile LAS unsigned char*)(F.lds + SU_SEL); volatile LAS int* list = (volatile LAS int*)(F.lds + SU_LIST);
    LAS bf16* Ql = (LAS bf16*)(F.lds + SU_Q) + lane * 8;
    const bf16* prow = F.PROJ + (size_t)row * NINB_PAD;
    __syncthreads();
    if (w == 0) {
#pragma unroll
        for (int s = 0; s < 4; ++s) *(LAS v4u*)(Ql + s * 512) = qscale8(*(const v4u*)(prow + head * 64 + 16 * s + 8 * h)); }
    for (int i = tid; i < 2048; i += 512) outL[i] = 0.f;
    for (int i = tid; i < 8 * 132; i += 512) impL[i] = 0.f;
    float gate[3];
#pragma unroll
    for (int j = 0; j < 3; ++j) gate[j] = sigmoidf_(bf2f(prow[CONV + head * 3 + j]));
    float m, l; f32x16 o[2];
    m = NEG_INF; l = 0.f; zero16(o[0]); zero16(o[1]);
    for (int ch = 0; ch < 2; ++ch) {
        __syncthreads(); su_stage<0>(F, b, kvh, ch, tid, list, 0); __syncthreads();
        const float fd0 = (float)(qpos - 31 - 16 * (ch * 256 + 32 * w + 4 * h));
        if (__any(colok && fd0 >= 0.f)) attn_blk<1, 512>(Ks + 32 * w * KP, VTs + 32 * w, SU_VTP, Ql, slope, fd0, colok, m, l, o, r, h);
    }
    su_merge<true>(F, w, lane, m, l, o, gate[0]);
    for (int ch = 0; ch < 2; ++ch) {
        __syncthreads(); su_stage<0>(F, b, kvh, ch, tid, list, 0); __syncthreads();
        const float fd0 = (float)(qpos - 31 - 16 * (ch * 256 + 32 * w + 4 * h));
        if (__any(colok && fd0 >= 0.f)) { f32x16 acc; zero16(acc);
#pragma unroll
            for (int s = 0; s < 4; ++s) acc = MFMA32(*(const LAS bf16x8*)(Ks + (32 * w + r) * KP + 16 * s + 8 * h), *(const LAS bf16x8*)(Ql + 512 * s), acc);
            const float Ms = ML[r], invL = ML[32 + r];
#pragma unroll
            for (int a = 0; a < 4; ++a) { float v = 0.f;
#pragma unroll
                for (int i2 = 0; i2 < 4; ++i2) { const int i = 4 * a + i2; const float dist = fd0 - 16.f * (float)((i & 3) + 8 * (i >> 2)); v += (colok && dist >= 0.f) ? __expf(acc[i] - slope * dist - Ms) * invL : 0.f; }
                const int base_ = (lane & 32) | qi;
                const float t0 = __shfl(v, base_), t1 = __shfl(v, base_ + 8), t2 = __shfl(v, base_ + 16);
                if (gq == 0) impL[qi * 132 + ch * 64 + 8 * w + 2 * a + h] = (t0 + t1) + t2; } }
    }
    __syncthreads();
    { const int cur = qpos >> 6;
      float mine[3];
#pragma unroll
      for (int jj = 0; jj < 3; ++jj) { const int sb = lane + 64 * jj; mine[jj] = NEG_INF;
          if (sb < 129) { const bool forced = sb == 0 || sb == cur || sb == cur - 1; mine[jj] = forced ? 1e4f : impL[w * 132 + sb]; } }
      LDS_WAIT();
#pragma unroll
      for (int jj = 0; jj < 3; ++jj) { const int sb = lane + 64 * jj; if (sb < 129) impL[w * 132 + sb] = mine[jj]; }
      LDS_WAIT();
#pragma unroll
      for (int jj = 0; jj < 3; ++jj) { const int sb = lane + 64 * jj;
          if (sb < 129) { int cnt = 0; for (int j = 0; j < 129; ++j) { const float ot = impL[w * 132 + j]; cnt += (ot > mine[jj] || (ot == mine[jj] && j < sb)) ? 1 : 0; }
              selL[w * 132 + sb] = cnt < 16 ? 1 : 0; } } }
    __syncthreads();
    if (w == 0) { int base = 0;
#pragma unroll
        for (int jj = 0; jj < 3; ++jj) { const int sb = lane + 64 * jj; bool any = false;
            if (sb < 129) { for (int q = 0; q < 8; ++q) any = any || selL[q * 132 + sb] != 0; }
            const unsigned long long mk = __ballot(any);
            if (any) list[base + __popcll(mk & ((1ull << lane) - 1ull))] = sb;
            base += __popcll(mk); }
        if (lane == 0) list[131] = base; }
    __syncthreads();
    const int count = list[131];
    m = NEG_INF; l = 0.f; zero16(o[0]); zero16(o[1]);
    for (int ch = 0; ch * 4 < count; ++ch) {
        __syncthreads(); su_stage<1>(F, b, kvh, ch, tid, list, count); __syncthreads();
        const int e = ch * 4 + (w >> 1);
        if (e < count) { const int sb = list[e]; const bool ok = colok && selL[qi * 132 + sb] != 0; const float fd0 = (float)(qpos - (64 * sb + 32 * (w & 1) + 4 * h));
            if (__any(ok && fd0 >= 0.f)) attn_blk<2, 512>(Ks + 32 * w * KP, VTs + 32 * w, SU_VTP, Ql, slope, fd0, ok, m, l, o, r, h); }
    }
    su_merge<false>(F, w, lane, m, l, o, gate[1]);
    m = NEG_INF; l = 0.f; zero16(o[0]); zero16(o[1]);
    for (int ch = 0; ch < 3; ++ch) {
        __syncthreads(); su_stage<2>(F, b, kvh, ch, tid, list, 0); __syncthreads();
        const float fd0 = (float)(qpos - (PAST - 512 + ch * 256 + 32 * w + 4 * h));
        if (__any(colok && fd0 >= 0.f && fd0 - 27.f <= 512.f)) attn_blk<3, 512>(Ks + 32 * w * KP, VTs + 32 * w, SU_VTP, Ql, slope, fd0, colok, m, l, o, r, h);
    }
    su_merge<false>(F, w, lane, m, l, o, gate[2]);
    if (colok) {
#pragma unroll
        for (int db = 0; db < 2; ++db)
#pragma unroll
            for (int s2 = 0; s2 < 2; ++s2) { const int s = 2 * w + s2, d = db * 32 + (s & 3) + 8 * (s >> 2) + 4 * h;
                F.Y[(size_t)row * D + head * 64 + d] = (bf16)f2bf(outL[(db * 16 + s) * 64 + lane]); } }
    __syncthreads();
}

__device__ __forceinline__ void nsa_phase(Frame& F, int l) {
#if NSA_NAIVE
    LAS float* wl = (LAS float*)F.lds + F.wave * 2304;
    const int gw = F.vcu * NWAVES + F.wave, NGW = F.G * NWAVES;
    for (int task = gw; task < MS * 4; task += NGW) { const int kvh = task & 3, r = task >> 2; nsa_task<true>(F, r >> 3, r & 7, kvh, wl); }
    for (int task = gw; task < MP * 4; task += NGW) { const int kvh = task & 3, r = task >> 2; nsa_task<false>(F, r >> 12, r & 4095, kvh, wl); }
    __syncthreads();
#else
    for (int rep = 0; rep < REP_PNSA; ++rep)
    for (int unit = F.vcu; unit < 256; unit += F.G) { Frame F2 = mkframe(F.lds, F.wave); nsa_prompt_unit(F2, 255 - unit); }
    unsigned* ctr = (unsigned*)(F.ws + WS_CTL) + CW_QUEUE + l;
    volatile LAS int* qid = (volatile LAS int*)(F.lds + SU_QID);
    for (;;) { __syncthreads(); if (F.wave == 0 && lane_id() == 0) *qid = (int)atomicAdd(ctr, 1u); __syncthreads(); const int su = *qid; if (su >= BS * 4 * REP_SNSA) break;
        Frame F2 = mkframe(F.lds, F.wave); nsa_sample_unit(F2, su % (BS * 4)); }
#endif
}
__device__ __forceinline__ void final_phase(Frame& F, const float* g_final) {
    const int gw = F.vcu * NWAVES + F.wave, NGW = F.G * NWAVES, lane = F.lane;
    f32x4 g[4];
#pragma unroll
    for (int j = 0; j < 4; ++j) g[j] = *(const f32x4*)(g_final + j * 256 + lane * 4);
    for (int r = gw; r < M; r += 2 * NGW) {
        const int r2 = r + NGW; const bool two = r2 < M; const int rb = two ? r2 : r;
        const u64 q0 = F.rs[8 * M + r], q1 = F.rs[8 * M + rb];
        v2u xw[2][4];
#pragma unroll
        for (int j = 0; j < 4; ++j) { xw[0][j] = *(const v2u*)(F.XB + (size_t)r * D + j * 256 + lane * 4); xw[1][j] = *(const v2u*)(F.XB + (size_t)rb * D + j * 256 + lane * 4); }
        __builtin_amdgcn_sched_barrier(0);
#pragma unroll
        for (int i = 0; i < 2; ++i) if (i == 0 || two) { const int rr = i ? r2 : r; const float rstd = rsqrtf(from_fx(i ? q1 : q0) * (1.f / D) + RMS_EPS);
            float* dst = rr < MP ? F.out + OFF_YP + (size_t)rr * D : F.out + OFF_YS + (size_t)(rr - MP) * D;
#pragma unroll
            for (int j = 0; j < 4; ++j) { const f32x4 v = {bflo(xw[i][j].x), bfhi(xw[i][j].x), bflo(xw[i][j].y), bfhi(xw[i][j].y)};
                *(f32x4*)(dst + j * 256 + lane * 4) = v * rstd * g[j]; } } }
}

#define IN(k) (lo <= (k) && (k) < hi)
#define SEAM(k) do { if (!MK_PER_PHASE && IN(k) && IN((k) + 1)) { KArgs ka_ = (KArgs)__builtin_amdgcn_kernarg_segment_ptr(); asm volatile("" : "+s"(ka_)); \
        XcdBarrier bar_; bar_.bar = (unsigned*)(ka_->ws + WS_CTL) + CW_BAR; bar_.x = xb_xcc_id(); bar_.st = MISC + 8; bar_.tid = wv * 64 + lane_id(); xcd_barrier(bar_); } } while (0)
#define RUN_CMP_GEMM(P0, NP) do { EpiHid E_{(bf16*)(F.ws + WS_HIDB), (const float*)(F.ws + WS_CBIAS)}; pg8::Gemm g_{(const pg8::bf16_t*)(F.ws + WS_CMPA), (const pg8::bf16_t*)(F.ws + WS_WCMP), (int)(2 * NR), 512, 1024}; \
        CmpOrder S_{(P0), (NP), F.G, (int)blockIdx.x}; pg8::gemm_phase<EpiHid, CmpOrder, true, true>(F.lds, g_, S_, E_, F.tid); } while (0)
#define RUN_GEMM(EpiT, E, Ap, Bp, Mv, Nv, Kv) do { pg8::Gemm g_{(const pg8::bf16_t*)(Ap), (const pg8::bf16_t*)(Bp), (Mv), (Nv), (Kv)}; pg8::StaticOrder S_; S_.init((Mv), (Nv), F.G, (int)blockIdx.x); \
        pg8::gemm_phase<EpiT, pg8::StaticOrder, true, true>(F.lds, g_, S_, E, F.tid); } while (0)


template <int l> __device__ __forceinline__ void run_layer(LAS unsigned char* const lds, volatile LAS unsigned* const MISC, const int wv, const int lo, const int hi) {
        constexpr int pb = 2 + 7 * l;
        if (IN(pb)) for (int rep = 0; rep < REP_INP; ++rep) {
            if (l == 0) { Frame F = mkframe(lds, wv); cmp_sample_fused_phase(F); }
            Frame F = mkframe(lds, wv);
            if (l < 2) { EpiInA E{F.PROJ, NINA, F.rs + (2 * l) * M}; RUN_GEMM(EpiInA, E, F.XB, (bf16*)(F.ws + WS_WINA) + (size_t)l * NINA * D, M, NINA, D);
                if (l == 0) { Frame F3 = mkframe(lds, wv); EpiMemKV E2{F3.out, F3.rs + 9 * M, (bf16*)(F3.ws + WS_MKB), (bf16*)(F3.ws + WS_MVT)};
                    pg8::Gemm g2{(const pg8::bf16_t*)F3.MEMB, (const pg8::bf16_t*)(F3.ws + WS_WMKV), 1024, 2048, D}; pg8::StaticOrder S2; S2.init(1024, 2048, F3.G, (int)((blockIdx.x + F3.G - 138u) % F3.G));
                    pg8::gemm_phase<EpiMemKV, pg8::StaticOrder, true, true>(F3.lds, g2, S2, E2, F3.tid); } }
            else { EpiInB E{F.PROJ, F.KVB, F.out, F.rs + (2 * l) * M, (bf16*)(F.ws + WS_VTB), (bf16*)(F.ws + WS_CMPA), (bf16*)(F.ws + WS_KTB)}; RUN_GEMM(EpiInB, E, F.XB, F.ws + (l == 2 ? WS_WINB2 : WS_WINB3), M, (l == 2 ? NB2 : NINB_PAD), D); }
        }
        SEAM(pb);
        if (l == 2) {
            if (IN(pb + 1)) { { Frame F = mkframe(lds, wv); RUN_CMP_GEMM(0, 16); }
                              { Frame F2 = mkframe(lds, wv); memattn_mfma_phase(F2, l, NINB_PAD, CONV + 36, (unsigned*)(F2.ws + WS_CTL) + CW_QUEUE + 8 + l); }
                              { Frame F2 = mkframe(lds, wv); win_copy_phase(F2); }
                              { Frame F2 = mkframe(lds, wv); l3_weights_phase(F2); } }
            SEAM(pb + 1);
            if (IN(pb + 2)) for (int rep = 0; rep < REP_MISC; ++rep) { Frame F = mkframe(lds, wv); ctx2_mfma_phase(F, false); }
            SEAM(pb + 2);
        }
        if (IN(pb + 3)) { Frame F = mkframe(lds, wv);
#if MEM_NAIVE
            if (l < 2) { conv_phase(F, l, (const float*)F.ka->in[11]); memattn_phase(F, l, NINA, 3 * CONV); }
            else { nsa_phase(F, l); memattn_phase(F, l, NINB_PAD, CONV + 36); }
#else
            if (l < 2) { for (int rep = 0; rep < REP_MIX; ++rep) conv_phase(F, l, (const float*)F.ka->in[11]); } else { nsa_phase(F, l); }
            if (l != 2) for (int rep = 0; rep < REP_MIX; ++rep) { Frame F2 = mkframe(lds, wv); memattn_mfma_phase(F2, l, l < 2 ? NINA : NINB_PAD, l < 2 ? 3 * CONV : CONV + 36, l < 2 ? nullptr : (unsigned*)(F2.ws + WS_CTL) + CW_QUEUE + 8 + l); }
            if (l == 1) { Frame F2 = mkframe(lds, wv); ctx2_mfma_phase(F2, true); }
#endif
        }
        SEAM(pb + 3);
        if (IN(pb + 4)) { { Frame F = mkframe(lds, wv); EpiRes E{F.XB, F.rs + (2 * l + 1) * M}; RUN_GEMM(EpiRes, E, F.Y, (bf16*)(F.ws + WS_WO) + (size_t)l * D * D, MP, D, D); }
                          { Frame F = mkframe(lds, wv); sample_res_gemm(F, F.Y, D, (bf16*)(F.ws + WS_WO) + (size_t)l * D * D, F.rs + (2 * l + 1) * M); } }
        SEAM(pb + 4);
        if (IN(pb + 5)) for (int rep = 0; rep < REP_GU; ++rep) { Frame F = mkframe(lds, wv); EpiGU E{F.ACT, F.rs + (2 * l + 1) * M}; RUN_GEMM(EpiGU, E, F.XB, (bf16*)(F.ws + WS_WGU) + (size_t)l * NGU * D, M, NGU, D); }
        SEAM(pb + 5);
        if (l == 3 && FUSE_FINAL && !MK_PER_PHASE && (int)gridDim.x == 256) {
            if (IN(pb + 6)) { { Frame F = mkframe(lds, wv); EpiFinal E{F.XB, F.rs + 8 * M, F.out, (const float*)F.ka->in[27], (unsigned*)(F.ws + WS_CTL) + CW_FIN};
                                RUN_GEMM(EpiFinal, E, F.ACT, (bf16*)(F.ws + WS_WDN) + (size_t)l * D * FF, MP, D, FF); }
                              { Frame F = mkframe(lds, wv); sample_res_gemm<true>(F, F.ACT, FF, (bf16*)(F.ws + WS_WDN) + (size_t)l * D * FF, F.rs + 8 * M, (const float*)F.ka->in[27]); } }
            return; }
        if (IN(pb + 6)) { { Frame F = mkframe(lds, wv); EpiRes E{F.XB, F.rs + (2 * l + 2) * M}; RUN_GEMM(EpiRes, E, F.ACT, (bf16*)(F.ws + WS_WDN) + (size_t)l * D * FF, MP, D, FF); }
                          { Frame F = mkframe(lds, wv); sample_res_gemm(F, F.ACT, FF, (bf16*)(F.ws + WS_WDN) + (size_t)l * D * FF, F.rs + (2 * l + 2) * M); } }
        SEAM(pb + 6);
    }

__global__ void __launch_bounds__(NWAVES * 64, 2) yoco_fwd(Args a_unused) {
    extern __shared__ __attribute__((aligned(16))) unsigned char lds_raw[];
    LAS unsigned char* const lds = (LAS unsigned char*)lds_raw;
    volatile LAS unsigned* MISC = (volatile LAS unsigned*)(lds + MISC_OFF);
    const int wv = __builtin_amdgcn_readfirstlane((int)threadIdx.x >> 6);
    if (threadIdx.x < 32) MISC[threadIdx.x] = 0u;
    __syncthreads();
    int lo, hi;
    { KArgs ka = (KArgs)__builtin_amdgcn_kernarg_segment_ptr(); lo = ka->ph_lo; hi = ka->ph_hi;
      if (!MK_PER_PHASE) (void)xcd_barrier_post((unsigned*)(ka->ws + WS_CTL) + CW_BAR, MISC + 8, (int)threadIdx.x); }
    if (IN(0)) { for (int rep = 0; rep < REP_PRO; ++rep) { Frame F = mkframe(lds, wv); prologue(F); __syncthreads(); } }
    SEAM(0);
    run_layer<0>(lds, MISC, wv, lo, hi); run_layer<1>(lds, MISC, wv, lo, hi); run_layer<2>(lds, MISC, wv, lo, hi); run_layer<3>(lds, MISC, wv, lo, hi);
    if (FUSE_FINAL && !MK_PER_PHASE && (int)gridDim.x == 256) return;
    if (IN(NPH - 1)) for (int rep = 0; rep < REP_MISC; ++rep) { Frame F = mkframe(lds, wv); final_phase(F, (const float*)F.ka->in[27]); }
}

extern "C" void kernel_launch(void* const* d_in, const int* in_sizes, int n_in, void* d_out, int out_size, void* d_ws, size_t ws_size, hipStream_t stream) {
    static int grid = 0;
    if (grid == 0) {
        if (n_in != 28 || out_size != (int)OUT_TOTAL || ws_size < WS_END) { fprintf(stderr, "kernel_launch: unexpected shapes: n_in %d out %d ws %zu (need %zu)\n", n_in, out_size, ws_size, (size_t)WS_END); grid = -1; return; }
        int dev = 0, cus = 0, per_cu = 0;
        if (hipGetDevice(&dev) != hipSuccess || hipDeviceGetAttribute(&cus, hipDeviceAttributeMultiprocessorCount, dev) != hipSuccess) { grid = -1; return; }
        if (hipFuncSetAttribute((const void*)yoco_fwd, hipFuncAttributeMaxDynamicSharedMemorySize, LDS_BYTES) != hipSuccess) { fprintf(stderr, "kernel_launch: hipFuncSetAttribute failed\n"); grid = -1; return; }
        if (hipOccupancyMaxActiveBlocksPerMultiprocessor(&per_cu, (const void*)yoco_fwd, NWAVES * 64, LDS_BYTES) != hipSuccess || per_cu < 1) fprintf(stderr, "kernel_launch: occupancy query reports %d\n", per_cu);
        (void)hipGetLastError();
        grid = cus;
    }
    if (grid < 0) return;
    if (hipMemsetAsync((char*)d_ws + WS_CTL, 0, CTL_BYTES, stream) != hipSuccess) return;
    Args a{};
    for (int i = 0; i < 28; ++i) a.in[i] = d_in[i];
    a.out = (float*)d_out; a.ws = (unsigned char*)d_ws; a.li = 0; a.pad = 0;
#if MK_PER_PHASE
    for (int p = 0; p < NPH; ++p) {
        const int k = (p - 2) % 7;
        if (p >= 2 && p < NPH - 1 && (k == 1 || k == 2) && (p - 2) / 7 != 2) continue;
        a.ph_lo = p; a.ph_hi = p + 1;
        hipLaunchKernelGGL(yoco_fwd, dim3(grid), dim3(NWAVES * 64), LDS_BYTES, stream, a);
    }
#else
    a.ph_lo = 0; a.ph_hi = NPH;
    hipLaunchKernelGGL(yoco_fwd, dim3(grid), dim3(NWAVES * 64), LDS_BYTES, stream, a);
#endif
    const hipError_t le = hipPeekAtLastError();
    if (le != hipSuccess) fprintf(stderr, "kernel_launch: launch failed: %s\n", hipGetErrorName(le));
}
```
